# Optimizing an MI355X kernel written in HIP

```python
import jax, jax.numpy as jnp
from jax import lax
import numpy as np


D_MODEL = 1024
BATCH = 2
SEQ = 8192
DEPTH = 2

N_MIXERS = 2
N_LAYERS_A = (DEPTH + 1) // 2
N_LAYERS_B = DEPTH // 2
MLA_HEADS = 8
QK_NOPE = 128
QK_ROPE = 64
V_DIM = 128
Q_LORA = 384
KV_LORA = 256
ROPE_THETA = 10000.0
SWA_HEADS = 16
SWA_KV_HEADS = 4
SWA_HEAD_DIM = 64
WINDOW = 128
D_FF = 4 * D_MODEL
BLOCK_Q = 128
EPS = 1e-6

kernel_name = 'hybrid_mla_swa_sink_alibi_adaln'


def rmsnorm(x, g):
    xf = x.astype(jnp.float32)
    y = xf * lax.rsqrt(jnp.mean(xf * xf, axis=-1, keepdims=True) + EPS)
    return (y * g.astype(jnp.float32)).astype(x.dtype)


def modulate(x, g, shift, scale):
    return rmsnorm(x, g) * (1.0 + scale[:, None, :]) + shift[:, None, :]


def rope(x, positions):
    half = QK_ROPE // 2
    inv_freq = ROPE_THETA ** (-jnp.arange(half, dtype=jnp.float32) / half)
    ang = positions.astype(jnp.float32)[..., None] * inv_freq
    shape = ang.shape[:2] + (1,) * (x.ndim - 3) + (half,)
    cos = jnp.cos(ang).reshape(shape)
    sin = jnp.sin(ang).reshape(shape)
    xf = x.astype(jnp.float32)
    x1, x2 = xf[..., :half], xf[..., half:]
    out = jnp.concatenate([x1 * cos - x2 * sin, x1 * sin + x2 * cos], axis=-1)
    return out.astype(x.dtype)


def alibi_slopes(n_heads):
    return jnp.asarray(2.0 ** (-8.0 * np.arange(1, n_heads + 1) / n_heads), dtype=jnp.float32)


def mla(h, positions, w_dq, g_q, w_uq, w_dkv, g_kv, w_ukv, w_o):
    B, S, _ = h.shape
    H = MLA_HEADS
    cq = rmsnorm(h @ w_dq, g_q)
    q = (cq @ w_uq).reshape(B, S, H, QK_NOPE + QK_ROPE)
    q_nope = q[..., :QK_NOPE]
    q_rope = rope(q[..., QK_NOPE:], positions)
    ckv_kr = h @ w_dkv
    ckv = rmsnorm(ckv_kr[..., :KV_LORA], g_kv)
    k_rope = rope(ckv_kr[..., KV_LORA:], positions)
    kv = (ckv @ w_ukv).reshape(B, S, H, QK_NOPE + V_DIM)
    k_nope, v = kv[..., :QK_NOPE], kv[..., QK_NOPE:]
    scale = (QK_NOPE + QK_ROPE) ** -0.5
    n_blk = S // BLOCK_Q
    qn_blk = q_nope.reshape(B, n_blk, BLOCK_Q, H, QK_NOPE).transpose(1, 0, 2, 3, 4)
    qr_blk = q_rope.reshape(B, n_blk, BLOCK_Q, H, QK_ROPE).transpose(1, 0, 2, 3, 4)
    key_idx = jnp.arange(S)

    def one_block(args):
        i, qn, qr = args
        s = (jnp.einsum('bqhd,bkhd->bhqk', qn, k_nope)
             + jnp.einsum('bqhr,bkr->bhqk', qr, k_rope)).astype(jnp.float32) * scale
        q_idx = i * BLOCK_Q + jnp.arange(BLOCK_Q)
        causal = key_idx[None, :] <= q_idx[:, None]
        s = jnp.where(causal[None, None], s, -jnp.inf)
        p = jax.nn.softmax(s, axis=-1).astype(v.dtype)
        return jnp.einsum('bhqk,bkhd->bqhd', p, v)

    o = lax.map(one_block, (jnp.arange(n_blk), qn_blk, qr_blk))
    o = o.transpose(1, 0, 2, 3, 4).reshape(B, S, H * V_DIM)
    return o @ w_o


def swa(h, w_qkv, b_qkv, sinks, w_o, b_o):
    B, S, _ = h.shape
    Hq, Hk, Dh, W = SWA_HEADS, SWA_KV_HEADS, SWA_HEAD_DIM, WINDOW
    G = Hq // Hk
    qkv = h @ w_qkv + b_qkv
    q = qkv[..., :Hq * Dh]
    k = qkv[..., Hq * Dh:(Hq + Hk) * Dh].reshape(B, S, Hk, Dh)
    v = qkv[..., (Hq + Hk) * Dh:].reshape(B, S, Hk, Dh)
    n_blk = S // W
    qb = q.reshape(B, n_blk, W, Hk, G, Dh)

    def band(t):
        tb = t.reshape(B, n_blk, W, Hk, Dh)
        prev = jnp.pad(tb[:, :-1], ((0, 0), (1, 0), (0, 0), (0, 0), (0, 0)))
        return jnp.concatenate([prev, tb], axis=2)

    kb, vb = band(k), band(v)
    s = jnp.einsum('bnqkgd,bnjkd->bnkgqj', qb, kb).astype(jnp.float32) * (Dh ** -0.5)
    dist = W + jnp.arange(W)[:, None] - jnp.arange(2 * W)[None, :]
    in_window = (dist >= 0) & (dist < W)
    real_key = (jnp.arange(n_blk)[:, None] > 0) | (jnp.arange(2 * W)[None, :] >= W)
    mask = in_window[None] & real_key[:, None, :]
    slopes = alibi_slopes(Hq).reshape(Hk, G)
    s = s - slopes[:, :, None, None] * dist.astype(jnp.float32)
    s = jnp.where(mask[None, :, None, None], s, -jnp.inf)
    sink = sinks.astype(jnp.float32).reshape(Hk, G)[:, :, None]
    m = jnp.maximum(s.max(axis=-1), sink)
    p = jnp.exp(s - m[..., None])
    denom = p.sum(axis=-1) + jnp.exp(sink - m)
    p = (p / denom[..., None]).astype(vb.dtype)
    o = jnp.einsum('bnkgqj,bnjkd->bnqkgd', p, vb).reshape(B, S, Hq * Dh)
    return o @ w_o + b_o


def setup_inputs(seed: int = 0) -> dict:
    key = jax.random.key(seed)
    ks = jax.random.split(key, 24)
    f32 = jnp.float32

    def w(k, shape, fan_in, gain=1.0):
        return jax.random.normal(k, shape, f32) * (gain * fan_in ** -0.5)

    def g(k, shape):
        return 1.0 + 0.05 * jax.random.normal(k, shape, f32)

    A, Bn = N_LAYERS_A, N_LAYERS_B
    x = jax.random.normal(ks[0], (BATCH, SEQ, D_MODEL), f32)
    c = jax.random.normal(ks[1], (BATCH, D_MODEL), f32)
    positions = (jnp.arange(SEQ, dtype=jnp.int32)[None, :]
                 + jax.random.randint(ks[2], (BATCH, 1), 0, 1024, dtype=jnp.int32))
    return {
        'x': x,
        'c': c,
        'positions': positions,
        'w_ada': w(ks[3], (DEPTH, D_MODEL, 6 * D_MODEL), D_MODEL, 0.5),
        'b_ada': 0.02 * jax.random.normal(ks[4], (DEPTH, 6 * D_MODEL), f32),
        'g_mix': g(ks[5], (DEPTH, D_MODEL)),
        'g_mlp': g(ks[6], (DEPTH, D_MODEL)),
        'mla_w_dq': w(ks[7], (A, D_MODEL, Q_LORA), D_MODEL),
        'mla_g_q': g(ks[8], (A, Q_LORA)),
        'mla_w_uq': w(ks[9], (A, Q_LORA, MLA_HEADS * (QK_NOPE + QK_ROPE)), Q_LORA),
        'mla_w_dkv': w(ks[10], (A, D_MODEL, KV_LORA + QK_ROPE), D_MODEL),
        'mla_g_kv': g(ks[11], (A, KV_LORA)),
        'mla_w_ukv': w(ks[12], (A, KV_LORA, MLA_HEADS * (QK_NOPE + V_DIM)), KV_LORA),
        'mla_w_o': w(ks[13], (A, MLA_HEADS * V_DIM, D_MODEL), MLA_HEADS * V_DIM),
        'swa_w_qkv': w(ks[14], (Bn, D_MODEL, (SWA_HEADS + 2 * SWA_KV_HEADS) * SWA_HEAD_DIM), D_MODEL),
        'swa_b_qkv': 0.02 * jax.random.normal(ks[15], (Bn, (SWA_HEADS + 2 * SWA_KV_HEADS) * SWA_HEAD_DIM), f32),
        'swa_sinks': 0.5 * jax.random.normal(ks[16], (Bn, SWA_HEADS), f32),
        'swa_w_o': w(ks[17], (Bn, SWA_HEADS * SWA_HEAD_DIM, D_MODEL), SWA_HEADS * SWA_HEAD_DIM),
        'swa_b_o': 0.02 * jax.random.normal(ks[18], (Bn, D_MODEL), f32),
        'w_ff1': w(ks[19], (DEPTH, D_MODEL, D_FF), D_MODEL),
        'w_ff2': w(ks[20], (DEPTH, D_FF, D_MODEL), D_FF),
        'g_final': g(ks[21], (D_MODEL,)),
    }


def reference(x, c, positions, w_ada, b_ada, g_mix, g_mlp,
              mla_w_dq, mla_g_q, mla_w_uq, mla_w_dkv, mla_g_kv, mla_w_ukv, mla_w_o,
              swa_w_qkv, swa_b_qkv, swa_sinks, swa_w_o, swa_b_o,
              w_ff1, w_ff2, g_final):
    cond = jax.nn.silu(c)
    for i in range(DEPTH):
        mod = cond @ w_ada[i] + b_ada[i]
        sh1, sc1, gt1, sh2, sc2, gt2 = jnp.split(mod, 6, axis=-1)
        h = modulate(x, g_mix[i], sh1, sc1)
        j = i // N_MIXERS
        if i % N_MIXERS == 0:
            y = mla(h, positions, mla_w_dq[j], mla_g_q[j], mla_w_uq[j], mla_w_dkv[j],
                    mla_g_kv[j], mla_w_ukv[j], mla_w_o[j])
        else:
            y = swa(h, swa_w_qkv[j], swa_b_qkv[j], swa_sinks[j], swa_w_o[j], swa_b_o[j])
        x = x + gt1[:, None, :] * y
        h = modulate(x, g_mlp[i], sh2, sc2)
        y = jnp.square(jax.nn.relu(h @ w_ff1[i])) @ w_ff2[i]
        x = x + gt2[:, None, :] * y
    return rmsnorm(x, g_final)
```

```cpp
#include <hip/hip_runtime.h>
#include <cstdio>
#include <cstdint>

typedef unsigned short bf16_t;
constexpr int BATCH = 2, SEQ = 8192, DM = 1024, M = BATCH * SEQ, FF = 4096;
constexpr int QL = 384, KVL = 256, NHM = 8, QKD = 192, VDM = 128;
constexpr int ND = 768;
constexpr int SHQ = 16, SHK = 4, SHD = 64, SWIN = 128;
constexpr float EPS = 1e-6f;
constexpr float LOG2E = 1.4426950408889634f;
constexpr float C2_MLA = 0.07216878364870322f * LOG2E;
constexpr float C2_SWA = 0.125f * LOG2E;

constexpr size_t MiB = 1u << 20;
constexpr size_t WS_CTL = 0, CTL_ZERO_BYTES = 1 * MiB;
constexpr size_t WS_MOD = 1 * MiB;
constexpr size_t WS_BIASD = WS_MOD + 2 * 2 * 6144 * 4;
constexpr size_t WS_BIASU = WS_BIASD + 2 * ND * 4;
constexpr size_t WS_BIASQ = WS_BIASU + 2 * 2 * FF * 4;
constexpr size_t WS_RSTDX = WS_BIASQ + 2 * 1536 * 4;
static_assert(WS_RSTDX + (size_t)M * 4 <= 2 * MiB, "small arrays");
constexpr size_t WS_SSQ1 = 2 * MiB;
constexpr size_t WS_SSQX = 4 * MiB;
constexpr size_t WS_ROPE = 5 * MiB;
constexpr size_t WS_WD = 9 * MiB, WS_WUQ = 11 * MiB, WS_WUKV = 13 * MiB, WS_WO0 = 14 * MiB, WS_W10 = 16 * MiB, WS_W20 = 24 * MiB,
                 WS_WQKV = 32 * MiB, WS_WO1 = 35 * MiB, WS_W11 = 37 * MiB, WS_W21 = 45 * MiB;
constexpr size_t WS_XN = 53 * MiB;
constexpr size_t WS_RAW = 85 * MiB;
constexpr size_t WS_O = 85 * MiB;
constexpr size_t WS_Q = 117 * MiB;
constexpr size_t WS_K = 165 * MiB;
constexpr size_t WS_V = 213 * MiB;
constexpr size_t WS_H = 85 * MiB;
constexpr size_t WS_Q1 = 117 * MiB, WS_K1 = 149 * MiB, WS_V1 = 157 * MiB;
constexpr size_t WS_END = 245 * MiB;

struct Params {
    const float *x, *c; const int* pos;
    const float *w_ada, *b_ada, *g_mix, *g_mlp, *w_dq, *g_q, *w_uq, *w_dkv, *g_kv, *w_ukv, *mla_w_o;
    const float *swa_w_qkv, *swa_b_qkv, *swa_sinks, *swa_w_o, *swa_b_o, *w_ff1, *w_ff2, *g_final;
    float* out; unsigned char* ws;
};

__device__ __forceinline__ float bf2f(bf16_t u) { return __uint_as_float((unsigned)u << 16); }
__device__ __forceinline__ unsigned f2bf(float f) { unsigned u = __float_as_uint(f); return (u + 0x7fffu + ((u >> 16) & 1u)) >> 16; }
__device__ __forceinline__ unsigned pk2(float lo, float hi) { return f2bf(lo) | (f2bf(hi) << 16); }

__host__ __device__ constexpr int w_N(int id) { return id == 0 ? ND : id == 1 ? 1536 : id == 2 ? 2048 : id == 3 ? 1024 : id == 4 ? FF : id == 5 ? 1024 : id == 6 ? 1536 : id == 7 ? 1024 : id == 8 ? FF : 1024; }
__host__ __device__ constexpr int w_K(int id) { return id == 0 ? 1024 : id == 1 ? QL : id == 2 ? KVL : id == 3 ? 1024 : id == 4 ? 1024 : id == 5 ? FF : id == 6 ? 1024 : id == 7 ? 1024 : id == 8 ? 1024 : FF; }
__host__ __device__ constexpr size_t w_off(int id) { return id == 0 ? WS_WD : id == 1 ? WS_WUQ : id == 2 ? WS_WUKV : id == 3 ? WS_WO0 : id == 4 ? WS_W10 : id == 5 ? WS_W20 : id == 6 ? WS_WQKV : id == 7 ? WS_WO1 : id == 8 ? WS_W11 : WS_W21; }

__device__ __forceinline__ int rope_src(int j) { return (j >> 1) + 32 * (j & 1); }

__device__ __forceinline__ float wsrc(const Params& p, int id, int k, int n) {
    switch (id) {
    case 0: if (n < 384) return p.w_dq[(size_t)k * 384 + n];
            if (n < 640) return p.w_dkv[(size_t)k * 320 + (n - 384)];
            if (n < 704) return p.w_dkv[(size_t)k * 320 + 256 + rope_src(n - 640)];
            return 0.f;
    case 1: { const int h = n / 192, cc = n % 192; const int src = cc < 128 ? n : h * 192 + 128 + rope_src(cc - 128); return p.g_q[k] * p.w_uq[(size_t)k * 1536 + src]; }
    case 2: return p.g_kv[k] * p.w_ukv[(size_t)k * 2048 + n];
    case 3: return p.mla_w_o[(size_t)k * 1024 + n];
    case 4: return p.w_ff1[(size_t)k * FF + n];
    case 5: return p.w_ff2[(size_t)k * 1024 + n];
    case 6: return p.swa_w_qkv[(size_t)k * 1536 + n];
    case 7: return p.swa_w_o[(size_t)k * 1024 + n];
    case 8: return p.w_ff1[(size_t)1024 * FF + (size_t)k * FF + n];
    default: return p.w_ff2[(size_t)FF * 1024 + (size_t)k * 1024 + n];
    }
}
__device__ __forceinline__ const float* modp(const Params& p, int l, int b, int part) { return (const float*)(p.ws + WS_MOD) + ((l * 2 + b) * 6 + part) * 1024; }
namespace nv {
__global__ void __launch_bounds__(256) wconv(Params p, int id, int pad) {
    const int N = w_N(id), K = w_K(id); const size_t e = (size_t)blockIdx.x * 256 + threadIdx.x;
    if (e >= (size_t)N * K) return;
    const int n = (int)(e / K), k = (int)(e % K);
    ((bf16_t*)(p.ws + w_off(id)))[e] = (bf16_t)f2bf(wsrc(p, id, k, n));
}
__global__ void __launch_bounds__(256) mod(Params p) {
    const int t = blockIdx.x * 256 + threadIdx.x; if (t >= 2 * 2 * 6144) return;
    const int n = t % 6144, b = (t / 6144) % 2, l = t / (2 * 6144);
    float s = 0.f;
    for (int k = 0; k < 1024; ++k) { const float cv = p.c[b * 1024 + k]; const float cond = cv / (1.f + __expf(-cv)); s += cond * p.w_ada[((size_t)l * 1024 + k) * 6144 + n]; }
    ((float*)(p.ws + WS_MOD))[(l * 2 + b) * 6144 + n] = s + p.b_ada[l * 6144 + n];
}
__global__ void __launch_bounds__(256) bias(Params p) {
    const int t = blockIdx.x * 256 + threadIdx.x;
    if (t < 2 * ND) { const int b = t / ND, n = t % ND; const float* sh = modp(p, 0, b, 0); float s = 0.f; for (int k = 0; k < 1024; ++k) s += sh[k] * wsrc(p, 0, k, n);
        ((float*)(p.ws + WS_BIASD))[t] = s; return; }
    int u = t - 2 * ND;
    if (u < 2 * 2 * FF) { const int n = u % FF, b = (u / FF) % 2, l = u / (2 * FF); const float* sh = modp(p, l, b, 3); float s = 0.f; for (int k = 0; k < 1024; ++k) s += sh[k] * wsrc(p, l == 0 ? 4 : 8, k, n);
        ((float*)(p.ws + WS_BIASU))[u] = s; return; }
    u -= 2 * 2 * FF;
    if (u < 2 * 1536) { const int b = u / 1536, n = u % 1536; const float* sh = modp(p, 1, b, 0); float s = 0.f; for (int k = 0; k < 1024; ++k) s += sh[k] * wsrc(p, 6, k, n);
        ((float*)(p.ws + WS_BIASQ))[u] = s + p.swa_b_qkv[n]; }
}
__global__ void __launch_bounds__(256) prep0(Params p) {
    const int lane = threadIdx.x & 63, row = blockIdx.x * 4 + (threadIdx.x >> 6), b = row / SEQ;
    const float* xr = p.x + (size_t)row * DM; float s = 0.f;
    for (int i = lane; i < DM; i += 64) s += xr[i] * xr[i];
    for (int o = 1; o < 64; o <<= 1) s += __shfl_xor(s, o);
    if (lane == 0) ((float*)(p.ws + WS_RSTDX))[row] = 1.f / sqrtf(s * (1.f / DM) + EPS);
    const float* sc = modp(p, 0, b, 1); bf16_t* xn = (bf16_t*)(p.ws + WS_XN) + (size_t)row * DM;
    for (int i = lane; i < DM; i += 64) xn[i] = (bf16_t)f2bf(xr[i] * (p.g_mix[i] * (1.f + sc[i])));
    if (lane < 32) { const float inv = powf(10000.f, -(float)lane / 32.f); const float ang = (float)p.pos[row] * inv;
        float* r = (float*)(p.ws + WS_ROPE) + ((size_t)row * 32 + lane) * 2; r[0] = cosf(ang); r[1] = sinf(ang); }
}
__global__ void __launch_bounds__(256) ssq1(Params p) {
    const int lane = threadIdx.x & 63, row = blockIdx.x * 4 + (threadIdx.x >> 6);
    const bf16_t* r = (const bf16_t*)(p.ws + WS_RAW) + (size_t)row * ND; float a = 0.f, c = 0.f;
    for (int i = lane; i < 384; i += 64) { const float v = bf2f(r[i]); a += v * v; }
    for (int i = 384 + lane; i < 640; i += 64) { const float v = bf2f(r[i]); c += v * v; }
    for (int o = 1; o < 64; o <<= 1) { a += __shfl_xor(a, o); c += __shfl_xor(c, o); }
    float* q = (float*)(p.ws + WS_SSQ1) + (size_t)row * 24;
    if (lane < 24) q[lane] = lane == 0 ? a : lane == 12 ? c : 0.f;
}
__global__ void __launch_bounds__(256) ssqx(Params p) {
    const int lane = threadIdx.x & 63, row = blockIdx.x * 4 + (threadIdx.x >> 6);
    const float* xr = p.out + (size_t)row * DM; float s = 0.f;
    for (int i = lane; i < DM; i += 64) s += xr[i] * xr[i];
    for (int o = 1; o < 64; o <<= 1) s += __shfl_xor(s, o);
    float* q = (float*)(p.ws + WS_SSQX) + (size_t)row * 16;
    if (lane < 16) q[lane] = lane == 0 ? s : 0.f;
}
__device__ __forceinline__ float rstd_x16(const Params& p, int row) { const float* q = (const float*)(p.ws + WS_SSQX) + (size_t)row * 16; float s = 0.f;
#pragma unroll
    for (int i = 0; i < 16; ++i) s += q[i]; return 1.f / sqrtf(s * (1.f / DM) + EPS); }
__global__ void __launch_bounds__(256) final_norm(Params p) {
    const int lane = threadIdx.x & 63, row = blockIdx.x * 4 + (threadIdx.x >> 6);
    const float r = rstd_x16(p, row); float* xr = p.out + (size_t)row * DM;
    for (int i = lane; i < DM; i += 64) xr[i] = xr[i] * r * p.g_final[i];
}

struct E1 { Params p;
    __device__ void operator()(int row, int col, const float* a) const {
        const int b = row / SEQ; const float r = ((const float*)(p.ws + WS_RSTDX))[row]; const float* bd = (const float*)(p.ws + WS_BIASD) + b * ND;
        float v[4];
#pragma unroll
        for (int i = 0; i < 4; ++i) v[i] = r * a[i] + bd[col + i];
        if (col < 640) { bf16_t* o = (bf16_t*)(p.ws + WS_RAW) + (size_t)row * ND + col;
#pragma unroll
            for (int i = 0; i < 4; ++i) o[i] = (bf16_t)f2bf(v[i]); }
        else if (col < 704) { const int j = col - 640;
#pragma unroll
            for (int pr = 0; pr < 2; ++pr) { const int i = (j >> 1) + pr; const float* cs = (const float*)(p.ws + WS_ROPE) + ((size_t)row * 32 + i) * 2;
                const float x1 = v[2 * pr], x2 = v[2 * pr + 1], o1 = x1 * cs[0] - x2 * cs[1], o2 = x1 * cs[1] + x2 * cs[0];
                for (int h = 0; h < NHM; ++h) { bf16_t* o = (bf16_t*)(p.ws + WS_K) + (size_t)row * 1536 + h * 192 + 128 + j + 2 * pr; o[0] = (bf16_t)f2bf(o1); o[1] = (bf16_t)f2bf(o2); } } }
    }
};
struct E2q { Params p;
    __device__ void operator()(int row, int col, const float* a) const {
        const float* q = (const float*)(p.ws + WS_SSQ1) + (size_t)row * 24; float s = 0.f;
#pragma unroll
        for (int i = 0; i < 12; ++i) s += q[i];
        const float r = 1.f / sqrtf(s * (1.f / QL) + EPS); float v[4];
#pragma unroll
        for (int i = 0; i < 4; ++i) v[i] = r * a[i];
        const int cc = col % 192;
        if (cc >= 128) { const int j = cc - 128;
#pragma unroll
            for (int pr = 0; pr < 2; ++pr) { const int i = (j >> 1) + pr; const float* cs = (const float*)(p.ws + WS_ROPE) + ((size_t)row * 32 + i) * 2;
                const float x1 = v[2 * pr], x2 = v[2 * pr + 1]; v[2 * pr] = x1 * cs[0] - x2 * cs[1]; v[2 * pr + 1] = x1 * cs[1] + x2 * cs[0]; } }
        bf16_t* o = (bf16_t*)(p.ws + WS_Q) + (size_t)row * 1536 + col;
#pragma unroll
        for (int i = 0; i < 4; ++i) o[i] = (bf16_t)f2bf(v[i] * C2_MLA);
    }
};
struct E2kv { Params p;
    __device__ void operator()(int row, int col, const float* a) const {
        const float* q = (const float*)(p.ws + WS_SSQ1) + (size_t)row * 24; float s = 0.f;
#pragma unroll
        for (int i = 12; i < 20; ++i) s += q[i];
        const float r = 1.f / sqrtf(s * (1.f / KVL) + EPS);
        const int h = col / 256, cc = col % 256;
        bf16_t* o = cc < 128 ? (bf16_t*)(p.ws + WS_K) + (size_t)row * 1536 + h * 192 + cc : (bf16_t*)(p.ws + WS_V) + (size_t)row * 1024 + h * 128 + (cc - 128);
#pragma unroll
        for (int i = 0; i < 4; ++i) o[i] = (bf16_t)f2bf(r * a[i]);
    }
};
struct E4 { Params p; int l, pad;
    __device__ void operator()(int row, int col, const float* a) const {
        const int b = row / SEQ; const float* gt = modp(p, l, b, 2) + col; const float* sc = modp(p, l, b, 4) + col; const float* g = p.g_mlp + l * 1024 + col;
        const float* xin = (l == 0 ? p.x : p.out) + (size_t)row * DM + col; float* xo = p.out + (size_t)row * DM + col; bf16_t* xn = (bf16_t*)(p.ws + WS_XN) + (size_t)row * DM + col;
#pragma unroll
        for (int i = 0; i < 4; ++i) { const float y = a[i] + (l == 1 ? p.swa_b_o[col + i] : 0.f); const float x1 = xin[i] + gt[i] * y; xo[i] = x1; xn[i] = (bf16_t)f2bf(x1 * (g[i] * (1.f + sc[i]))); }
    }
};
struct E5 { Params p; int l, pad;
    __device__ void operator()(int row, int col, const float* a) const {
        const int b = row / SEQ; const float r = rstd_x16(p, row); const float* bu = (const float*)(p.ws + WS_BIASU) + (l * 2 + b) * FF + col;
        bf16_t* o = (bf16_t*)(p.ws + WS_H) + (size_t)row * FF + col;
#pragma unroll
        for (int i = 0; i < 4; ++i) { const float v = fmaxf(r * a[i] + bu[i], 0.f); o[i] = (bf16_t)f2bf(v * v); }
    }
};
struct E6 { Params p; int l, pad;
    __device__ void operator()(int row, int col, const float* a) const {
        const int b = row / SEQ; const float* gt = modp(p, l, b, 5) + col; float* xo = p.out + (size_t)row * DM + col;
        float x2[4];
#pragma unroll
        for (int i = 0; i < 4; ++i) { x2[i] = xo[i] + gt[i] * a[i]; xo[i] = x2[i]; }
        if (l == 0) { const float* sc = modp(p, 1, b, 1) + col; const float* g = p.g_mix + 1024 + col; bf16_t* xn = (bf16_t*)(p.ws + WS_XN) + (size_t)row * DM + col;
#pragma unroll
            for (int i = 0; i < 4; ++i) xn[i] = (bf16_t)f2bf(x2[i] * (g[i] * (1.f + sc[i]))); }
    }
};
struct E7 { Params p;
    __device__ void operator()(int row, int col, const float* a) const {
        const int b = row / SEQ; const float r = rstd_x16(p, row); const float* bq = (const float*)(p.ws + WS_BIASQ) + b * 1536 + col;
        bf16_t* o; float sc = 1.f;
        if (col < 1024) { o = (bf16_t*)(p.ws + WS_Q1) + (size_t)row * 1024 + col; sc = C2_SWA; }
        else if (col < 1280) o = (bf16_t*)(p.ws + WS_K1) + (size_t)row * 256 + (col - 1024);
        else o = (bf16_t*)(p.ws + WS_V1) + (size_t)row * 256 + (col - 1280);
#pragma unroll
        for (int i = 0; i < 4; ++i) o[i] = (bf16_t)f2bf((r * a[i] + bq[i]) * sc);
    }
};
template <class Epi>
__global__ void __launch_bounds__(256) gemm(const bf16_t* A, const bf16_t* Wt, int lda, int N, int K, int pad, Epi E) {
    __shared__ float As[16][68], Ws[16][68];
    const int tx = threadIdx.x & 15, ty = threadIdx.x >> 4, row0 = blockIdx.y * 64, col0 = blockIdx.x * 64;
    float acc[4][4];
#pragma unroll
    for (int i = 0; i < 4; ++i)
#pragma unroll
        for (int j = 0; j < 4; ++j) acc[i][j] = 0.f;
    for (int k0 = 0; k0 < K; k0 += 16) {
#pragma unroll
        for (int i = 0; i < 4; ++i) { const int e = threadIdx.x + 256 * i, r = e >> 4, kk = e & 15;
            As[kk][r] = bf2f(A[(size_t)(row0 + r) * lda + k0 + kk]); Ws[kk][r] = bf2f(Wt[(size_t)(col0 + r) * K + k0 + kk]); }
        __syncthreads();
#pragma unroll
        for (int kk = 0; kk < 16; ++kk) { float a[4], w[4];
#pragma unroll
            for (int i = 0; i < 4; ++i) { a[i] = As[kk][ty * 4 + i]; w[i] = Ws[kk][tx * 4 + i]; }
#pragma unroll
            for (int i = 0; i < 4; ++i)
#pragma unroll
                for (int j = 0; j < 4; ++j) acc[i][j] += a[i] * w[j]; }
        __syncthreads();
    }
#pragma unroll
    for (int i = 0; i < 4; ++i) { float v[4] = {acc[i][0], acc[i][1], acc[i][2], acc[i][3]}; E(row0 + ty * 4 + i, col0 + tx * 4, v); }
}
template <bool SWA>
__global__ void __launch_bounds__(256) attn(Params p) {
    constexpr int DQ = SWA ? 64 : 192, DV = SWA ? 64 : 128, NQ = DQ / 64, NV = DV / 64, H = SWA ? SHQ : NHM;
    constexpr int QP = SWA ? 1024 : 1536, KP = SWA ? 256 : 1536, VP = SWA ? 256 : 1024;
    const int lane = threadIdx.x & 63; const long gid = (long)blockIdx.x * 4 + (threadIdx.x >> 6);
    const int q = (int)(gid % SEQ), h = (int)((gid / SEQ) % H), b = (int)(gid / ((long)SEQ * H));
    const bf16_t* Qr = (const bf16_t*)(p.ws + (SWA ? WS_Q1 : WS_Q)) + (size_t)(b * SEQ + q) * QP + h * DQ;
    const bf16_t* Kb = (const bf16_t*)(p.ws + (SWA ? WS_K1 : WS_K)) + (size_t)b * SEQ * KP + (SWA ? (h / 4) * 64 : h * 192);
    const bf16_t* Vb = (const bf16_t*)(p.ws + (SWA ? WS_V1 : WS_V)) + (size_t)b * SEQ * VP + (SWA ? (h / 4) * 64 : h * 128);
    bf16_t* Or = (bf16_t*)(p.ws + WS_O) + (size_t)(b * SEQ + q) * 1024 + h * DV;
    float qv[NQ];
#pragma unroll
    for (int i = 0; i < NQ; ++i) qv[i] = bf2f(Qr[lane + 64 * i]);
    const int jlo = SWA ? (q - (SWIN - 1) > 0 ? q - (SWIN - 1) : 0) : 0;
    const float slope2 = SWA ? exp2f(-0.5f * (float)(h + 1)) * LOG2E : 0.f;
    float m = SWA ? p.swa_sinks[h] * LOG2E : -1e30f, l = SWA ? 1.f : 0.f; float o[NV];
#pragma unroll
    for (int i = 0; i < NV; ++i) o[i] = 0.f;
    for (int j0 = jlo; j0 <= q; j0 += 64) {
        const int j = j0 + lane; const bool valid = j <= q; const int jc = valid ? j : q;
        const uint4* kr = (const uint4*)(Kb + (size_t)jc * KP); float s = 0.f;
#pragma unroll
        for (int c8 = 0; c8 < DQ / 8; ++c8) { const uint4 kk = kr[c8]; const unsigned w[4] = {kk.x, kk.y, kk.z, kk.w};
#pragma unroll
            for (int e = 0; e < 8; ++e) { const int d = c8 * 8 + e; const float qd = __uint_as_float(__builtin_amdgcn_readlane(__float_as_uint(qv[d / 64]), d % 64));
                const float kd = (e & 1) ? __uint_as_float(w[e >> 1] & 0xffff0000u) : __uint_as_float(w[e >> 1] << 16); s += qd * kd; } }
        if (SWA) s -= slope2 * (float)(q - j);
        if (!valid) s = -__builtin_inff();
        float mx = s;
        for (int t = 1; t < 64; t <<= 1) mx = fmaxf(mx, __shfl_xor(mx, t));
        const float mn = fmaxf(m, mx), alpha = exp2f(m - mn), pj = exp2f(s - mn);
        float ps = pj;
        for (int t = 1; t < 64; t <<= 1) ps += __shfl_xor(ps, t);
        l = l * alpha + ps; m = mn;
#pragma unroll
        for (int i = 0; i < NV; ++i) o[i] *= alpha;
        for (int jj = 0; jj < 64; ++jj) { const float pb = __shfl(pj, jj); int r = j0 + jj; r = r <= q ? r : q; const bf16_t* vr = Vb + (size_t)r * VP;
#pragma unroll
            for (int i = 0; i < NV; ++i) o[i] += pb * bf2f(vr[lane + 64 * i]); }
    }
    const float il = 1.f / l;
#pragma unroll
    for (int i = 0; i < NV; ++i) Or[lane + 64 * i] = (bf16_t)f2bf(o[i] * il);
}
}
static Params make_params(void* const* d_in, void* d_out, void* d_ws) {
    Params p{};
    p.x = (const float*)d_in[0]; p.c = (const float*)d_in[1]; p.pos = (const int*)d_in[2];
    p.w_ada = (const float*)d_in[3]; p.b_ada = (const float*)d_in[4]; p.g_mix = (const float*)d_in[5]; p.g_mlp = (const float*)d_in[6];
    p.w_dq = (const float*)d_in[7]; p.g_q = (const float*)d_in[8]; p.w_uq = (const float*)d_in[9]; p.w_dkv = (const float*)d_in[10];
    p.g_kv = (const float*)d_in[11]; p.w_ukv = (const float*)d_in[12]; p.mla_w_o = (const float*)d_in[13];
    p.swa_w_qkv = (const float*)d_in[14]; p.swa_b_qkv = (const float*)d_in[15]; p.swa_sinks = (const float*)d_in[16];
    p.swa_w_o = (const float*)d_in[17]; p.swa_b_o = (const float*)d_in[18]; p.w_ff1 = (const float*)d_in[19]; p.w_ff2 = (const float*)d_in[20];
    p.g_final = (const float*)d_in[21];
    p.out = (float*)d_out; p.ws = (unsigned char*)d_ws;
    return p;
}
template <class E> static void ngemm(hipStream_t st, const Params& p, size_t a_off, int lda, int wid, E e) {
    nv::gemm<E><<<dim3(w_N(wid) / 64, M / 64), 256, 0, st>>>((const bf16_t*)(p.ws + a_off), (const bf16_t*)(p.ws + w_off(wid)), lda, w_N(wid), w_K(wid), 0, e);
}
extern "C" void kernel_launch(void* const* d_in, const int* in_sizes, int n_in, void* d_out, int out_size, void* d_ws, size_t ws_size, hipStream_t stream) {
    if (n_in != 22 || in_sizes[0] != M * DM || out_size != M * DM || ws_size < WS_END) {
        fprintf(stderr, "kernel_launch: unexpected shapes (n_in %d, in0 %d, out %d, ws %zu)\n", n_in, n_in > 0 ? in_sizes[0] : -1, out_size, ws_size); return; }
    const Params p = make_params(d_in, d_out, d_ws);
    (void)hipMemsetAsync((char*)d_ws + WS_CTL, 0, CTL_ZERO_BYTES, stream);
    for (int id = 0; id < 10; ++id) nv::wconv<<<(unsigned)(((size_t)w_N(id) * w_K(id) + 255) / 256), 256, 0, stream>>>(p, id, 0);
    nv::mod<<<96, 256, 0, stream>>>(p);
    nv::bias<<<82, 256, 0, stream>>>(p);
    nv::prep0<<<M / 4, 256, 0, stream>>>(p);
    ngemm(stream, p, WS_XN, 1024, 0, nv::E1{p});
    nv::ssq1<<<M / 4, 256, 0, stream>>>(p);
    ngemm(stream, p, WS_RAW, ND, 1, nv::E2q{p});
    ngemm(stream, p, WS_RAW + 384 * 2, ND, 2, nv::E2kv{p});
    nv::attn<false><<<BATCH * NHM * SEQ / 4, 256, 0, stream>>>(p);
    ngemm(stream, p, WS_O, 1024, 3, nv::E4{p, 0, 0});
    nv::ssqx<<<M / 4, 256, 0, stream>>>(p);
    ngemm(stream, p, WS_XN, 1024, 4, nv::E5{p, 0, 0});
    ngemm(stream, p, WS_H, FF, 5, nv::E6{p, 0, 0});
    nv::ssqx<<<M / 4, 256, 0, stream>>>(p);
    ngemm(stream, p, WS_XN, 1024, 6, nv::E7{p});
    nv::attn<true><<<BATCH * SHQ * SEQ / 4, 256, 0, stream>>>(p);
    ngemm(stream, p, WS_O, 1024, 7, nv::E4{p, 1, 0});
    nv::ssqx<<<M / 4, 256, 0, stream>>>(p);
    ngemm(stream, p, WS_XN, 1024, 8, nv::E5{p, 1, 0});
    ngemm(stream, p, WS_H, FF, 9, nv::E6{p, 1, 0});
    nv::ssqx<<<M / 4, 256, 0, stream>>>(p);
    nv::final_norm<<<M / 4, 256, 0, stream>>>(p);
}
```

```cpp
#include <hip/hip_runtime.h>
#include <cstdio>
#include <cstdint>

typedef unsigned short bf16_t;
constexpr int BATCH = 2, SEQ = 8192, DM = 1024, M = BATCH * SEQ, FF = 4096;
constexpr int QL = 384, KVL = 256, NHM = 8, QKD = 192, VDM = 128;
constexpr int ND = 768;
constexpr int SHQ = 16, SHK = 4, SHD = 64, SWIN = 128;
constexpr float EPS = 1e-6f;
constexpr float LOG2E = 1.4426950408889634f;
constexpr float C2_MLA = 0.07216878364870322f * LOG2E;
constexpr float C2_SWA = 0.125f * LOG2E;

constexpr size_t MiB = 1u << 20;
constexpr size_t WS_CTL = 0, CTL_ZERO_BYTES = 1 * MiB;
constexpr size_t WS_MOD = 1 * MiB;
constexpr size_t WS_BIASD = WS_MOD + 2 * 2 * 6144 * 4;
constexpr size_t WS_BIASU = WS_BIASD + 2 * ND * 4;
constexpr size_t WS_BIASQ = WS_BIASU + 2 * 2 * FF * 4;
constexpr size_t WS_RSTDX = WS_BIASQ + 2 * 1536 * 4;
static_assert(WS_RSTDX + (size_t)M * 4 <= 2 * MiB, "small arrays");
constexpr size_t WS_SSQ1 = 2 * MiB;
constexpr size_t WS_SSQX = 4 * MiB;
constexpr size_t WS_ROPE = 5 * MiB;
constexpr size_t WS_WD = 9 * MiB, WS_WUQ = 11 * MiB, WS_WUKV = 13 * MiB, WS_WO0 = 14 * MiB, WS_W10 = 16 * MiB, WS_W20 = 24 * MiB,
                 WS_WQKV = 32 * MiB, WS_WO1 = 35 * MiB, WS_W11 = 37 * MiB, WS_W21 = 45 * MiB;
constexpr size_t WS_XN = 53 * MiB;
constexpr size_t WS_RAW = 85 * MiB;
constexpr size_t WS_O = 85 * MiB;
constexpr size_t WS_Q = 117 * MiB;
constexpr size_t WS_K = 165 * MiB;
constexpr size_t WS_V = 213 * MiB;
constexpr size_t WS_H = 85 * MiB;
constexpr size_t WS_Q1 = 117 * MiB, WS_K1 = 149 * MiB, WS_V1 = 157 * MiB;
constexpr size_t WS_END = 245 * MiB;

struct Params {
    const float *x, *c; const int* pos;
    const float *w_ada, *b_ada, *g_mix, *g_mlp, *w_dq, *g_q, *w_uq, *w_dkv, *g_kv, *w_ukv, *mla_w_o;
    const float *swa_w_qkv, *swa_b_qkv, *swa_sinks, *swa_w_o, *swa_b_o, *w_ff1, *w_ff2, *g_final;
    float* out; unsigned char* ws;
};

__device__ __forceinline__ float bf2f(bf16_t u) { return __uint_as_float((unsigned)u << 16); }
__device__ __forceinline__ unsigned f2bf(float f) { unsigned u = __float_as_uint(f); return (u + 0x7fffu + ((u >> 16) & 1u)) >> 16; }
__device__ __forceinline__ unsigned pk2(float lo, float hi) { return f2bf(lo) | (f2bf(hi) << 16); }

__host__ __device__ constexpr int w_N(int id) { return id == 0 ? ND : id == 1 ? 1536 : id == 2 ? 2048 : id == 3 ? 1024 : id == 4 ? FF : id == 5 ? 1024 : id == 6 ? 1536 : id == 7 ? 1024 : id == 8 ? FF : 1024; }
__host__ __device__ constexpr int w_K(int id) { return id == 0 ? 1024 : id == 1 ? QL : id == 2 ? KVL : id == 3 ? 1024 : id == 4 ? 1024 : id == 5 ? FF : id == 6 ? 1024 : id == 7 ? 1024 : id == 8 ? 1024 : FF; }
__host__ __device__ constexpr size_t w_off(int id) { return id == 0 ? WS_WD : id == 1 ? WS_WUQ : id == 2 ? WS_WUKV : id == 3 ? WS_WO0 : id == 4 ? WS_W10 : id == 5 ? WS_W20 : id == 6 ? WS_WQKV : id == 7 ? WS_WO1 : id == 8 ? WS_W11 : WS_W21; }

__device__ __forceinline__ int rope_src(int j) { return (j >> 1) + 32 * (j & 1); }

__device__ __forceinline__ float wsrc(const Params& p, int id, int k, int n) {
    switch (id) {
    case 0: if (n < 384) return p.w_dq[(size_t)k * 384 + n];
            if (n < 640) return p.w_dkv[(size_t)k * 320 + (n - 384)];
            if (n < 704) return p.w_dkv[(size_t)k * 320 + 256 + rope_src(n - 640)];
            return 0.f;
    case 1: { const int h = n / 192, cc = n % 192; const int src = cc < 128 ? n : h * 192 + 128 + rope_src(cc - 128); return p.g_q[k] * p.w_uq[(size_t)k * 1536 + src]; }
    case 2: return p.g_kv[k] * p.w_ukv[(size_t)k * 2048 + n];
    case 3: return p.mla_w_o[(size_t)k * 1024 + n];
    case 4: return p.w_ff1[(size_t)k * FF + n];
    case 5: return p.w_ff2[(size_t)k * 1024 + n];
    case 6: return p.swa_w_qkv[(size_t)k * 1536 + n];
    case 7: return p.swa_w_o[(size_t)k * 1024 + n];
    case 8: return p.w_ff1[(size_t)1024 * FF + (size_t)k * FF + n];
    default: return p.w_ff2[(size_t)FF * 1024 + (size_t)k * 1024 + n];
    }
}
__device__ __forceinline__ const float* modp(const Params& p, int l, int b, int part) { return (const float*)(p.ws + WS_MOD) + ((l * 2 + b) * 6 + part) * 1024; }
#define FAST_PHASES {1,1,1,1,1,1,1,1,1,1,1,1,1,1}
namespace nv {
__global__ void __launch_bounds__(256) wconv(Params p, int id, int pad) {
    const int N = w_N(id), K = w_K(id); const size_t e = (size_t)blockIdx.x * 256 + threadIdx.x;
    if (e >= (size_t)N * K) return;
    const int n = (int)(e / K), k = (int)(e % K);
    ((bf16_t*)(p.ws + w_off(id)))[e] = (bf16_t)f2bf(wsrc(p, id, k, n));
}
__global__ void __launch_bounds__(256) mod(Params p) {
    const int t = blockIdx.x * 256 + threadIdx.x; if (t >= 2 * 2 * 6144) return;
    const int n = t % 6144, b = (t / 6144) % 2, l = t / (2 * 6144);
    float s = 0.f;
    for (int k = 0; k < 1024; ++k) { const float cv = p.c[b * 1024 + k]; const float cond = cv / (1.f + __expf(-cv)); s += cond * p.w_ada[((size_t)l * 1024 + k) * 6144 + n]; }
    ((float*)(p.ws + WS_MOD))[(l * 2 + b) * 6144 + n] = s + p.b_ada[l * 6144 + n];
}
__global__ void __launch_bounds__(256) bias(Params p) {
    const int t = blockIdx.x * 256 + threadIdx.x;
    if (t < 2 * ND) { const int b = t / ND, n = t % ND; const float* sh = modp(p, 0, b, 0); float s = 0.f; for (int k = 0; k < 1024; ++k) s += sh[k] * wsrc(p, 0, k, n);
        ((float*)(p.ws + WS_BIASD))[t] = s; return; }
    int u = t - 2 * ND;
    if (u < 2 * 2 * FF) { const int n = u % FF, b = (u / FF) % 2, l = u / (2 * FF); const float* sh = modp(p, l, b, 3); float s = 0.f; for (int k = 0; k < 1024; ++k) s += sh[k] * wsrc(p, l == 0 ? 4 : 8, k, n);
        ((float*)(p.ws + WS_BIASU))[u] = s; return; }
    u -= 2 * 2 * FF;
    if (u < 2 * 1536) { const int b = u / 1536, n = u % 1536; const float* sh = modp(p, 1, b, 0); float s = 0.f; for (int k = 0; k < 1024; ++k) s += sh[k] * wsrc(p, 6, k, n);
        ((float*)(p.ws + WS_BIASQ))[u] = s + p.swa_b_qkv[n]; }
}
__global__ void __launch_bounds__(256) prep0(Params p) {
    const int lane = threadIdx.x & 63, row = blockIdx.x * 4 + (threadIdx.x >> 6), b = row / SEQ;
    const float* xr = p.x + (size_t)row * DM; float s = 0.f;
    for (int i = lane; i < DM; i += 64) s += xr[i] * xr[i];
    for (int o = 1; o < 64; o <<= 1) s += __shfl_xor(s, o);
    if (lane == 0) ((float*)(p.ws + WS_RSTDX))[row] = 1.f / sqrtf(s * (1.f / DM) + EPS);
    const float* sc = modp(p, 0, b, 1); bf16_t* xn = (bf16_t*)(p.ws + WS_XN) + (size_t)row * DM;
    for (int i = lane; i < DM; i += 64) xn[i] = (bf16_t)f2bf(xr[i] * (p.g_mix[i] * (1.f + sc[i])));
}
__global__ void __launch_bounds__(256) rope(Params p) {
    const int e = blockIdx.x * 256 + threadIdx.x, row = e >> 5, i = e & 31;
    const float inv = powf(10000.f, -(float)i / 32.f); const float ang = (float)p.pos[row] * inv;
    float* r = (float*)(p.ws + WS_ROPE) + (size_t)e * 2; r[0] = cosf(ang); r[1] = sinf(ang);
}
__global__ void __launch_bounds__(256) ssq1(Params p) {
    const int lane = threadIdx.x & 63, row = blockIdx.x * 4 + (threadIdx.x >> 6);
    const bf16_t* r = (const bf16_t*)(p.ws + WS_RAW) + (size_t)row * ND; float a = 0.f, c = 0.f;
    for (int i = lane; i < 384; i += 64) { const float v = bf2f(r[i]); a += v * v; }
    for (int i = 384 + lane; i < 640; i += 64) { const float v = bf2f(r[i]); c += v * v; }
    for (int o = 1; o < 64; o <<= 1) { a += __shfl_xor(a, o); c += __shfl_xor(c, o); }
    float* q = (float*)(p.ws + WS_SSQ1) + (size_t)row * 24;
    if (lane < 24) q[lane] = lane == 0 ? a : lane == 12 ? c : 0.f;
}
__global__ void __launch_bounds__(256) ssqx(Params p) {
    const int lane = threadIdx.x & 63, row = blockIdx.x * 4 + (threadIdx.x >> 6);
    const float* xr = p.out + (size_t)row * DM; float s = 0.f;
    for (int i = lane; i < DM; i += 64) s += xr[i] * xr[i];
    for (int o = 1; o < 64; o <<= 1) s += __shfl_xor(s, o);
    float* q = (float*)(p.ws + WS_SSQX) + (size_t)row * 16;
    if (lane < 16) q[lane] = lane == 0 ? s : 0.f;
}
__device__ __forceinline__ float rstd_x16(const Params& p, int row) { const float* q = (const float*)(p.ws + WS_SSQX) + (size_t)row * 16; float s = 0.f;
#pragma unroll
    for (int i = 0; i < 16; ++i) s += q[i]; return 1.f / sqrtf(s * (1.f / DM) + EPS); }
__global__ void __launch_bounds__(256) final_norm(Params p) {
    const int lane = threadIdx.x & 63, row = blockIdx.x * 4 + (threadIdx.x >> 6);
    const float r = rstd_x16(p, row); float* xr = p.out + (size_t)row * DM;
    for (int i = lane; i < DM; i += 64) xr[i] = xr[i] * r * p.g_final[i];
}

struct E1 { Params p;
    __device__ void operator()(int row, int col, const float* a) const {
        const int b = row / SEQ; const float r = ((const float*)(p.ws + WS_RSTDX))[row]; const float* bd = (const float*)(p.ws + WS_BIASD) + b * ND;
        float v[4];
#pragma unroll
        for (int i = 0; i < 4; ++i) v[i] = r * a[i] + bd[col + i];
        if (col < 640) { bf16_t* o = (bf16_t*)(p.ws + WS_RAW) + (size_t)row * ND + col;
#pragma unroll
            for (int i = 0; i < 4; ++i) o[i] = (bf16_t)f2bf(v[i]); }
        else if (col < 704) { const int j = col - 640;
#pragma unroll
            for (int pr = 0; pr < 2; ++pr) { const int i = (j >> 1) + pr; const float* cs = (const float*)(p.ws + WS_ROPE) + ((size_t)row * 32 + i) * 2;
                const float x1 = v[2 * pr], x2 = v[2 * pr + 1], o1 = x1 * cs[0] - x2 * cs[1], o2 = x1 * cs[1] + x2 * cs[0];
                for (int h = 0; h < NHM; ++h) { bf16_t* o = (bf16_t*)(p.ws + WS_K) + (size_t)row * 1536 + h * 192 + 128 + j + 2 * pr; o[0] = (bf16_t)f2bf(o1); o[1] = (bf16_t)f2bf(o2); } } }
    }
};
struct E2q { Params p;
    __device__ void operator()(int row, int col, const float* a) const {
        const float* q = (const float*)(p.ws + WS_SSQ1) + (size_t)row * 24; float s = 0.f;
#pragma unroll
        for (int i = 0; i < 12; ++i) s += q[i];
        const float r = 1.f / sqrtf(s * (1.f / QL) + EPS); float v[4];
#pragma unroll
        for (int i = 0; i < 4; ++i) v[i] = r * a[i];
        const int cc = col % 192;
        if (cc >= 128) { const int j = cc - 128;
#pragma unroll
            for (int pr = 0; pr < 2; ++pr) { const int i = (j >> 1) + pr; const float* cs = (const float*)(p.ws + WS_ROPE) + ((size_t)row * 32 + i) * 2;
                const float x1 = v[2 * pr], x2 = v[2 * pr + 1]; v[2 * pr] = x1 * cs[0] - x2 * cs[1]; v[2 * pr + 1] = x1 * cs[1] + x2 * cs[0]; } }
        bf16_t* o = (bf16_t*)(p.ws + WS_Q) + (size_t)row * 1536 + col;
#pragma unroll
        for (int i = 0; i < 4; ++i) o[i] = (bf16_t)f2bf(v[i] * C2_MLA);
    }
};
struct E2kv { Params p;
    __device__ void operator()(int row, int col, const float* a) const {
        const float* q = (const float*)(p.ws + WS_SSQ1) + (size_t)row * 24; float s = 0.f;
#pragma unroll
        for (int i = 12; i < 20; ++i) s += q[i];
        const float r = 1.f / sqrtf(s * (1.f / KVL) + EPS);
        const int h = col / 256, cc = col % 256;
        bf16_t* o = cc < 128 ? (bf16_t*)(p.ws + WS_K) + (size_t)row * 1536 + h * 192 + cc : (bf16_t*)(p.ws + WS_V) + (size_t)row * 1024 + h * 128 + (cc - 128);
#pragma unroll
        for (int i = 0; i < 4; ++i) o[i] = (bf16_t)f2bf(r * a[i]);
    }
};
struct E4 { Params p; int l, pad;
    __device__ void operator()(int row, int col, const float* a) const {
        const int b = row / SEQ; const float* gt = modp(p, l, b, 2) + col; const float* sc = modp(p, l, b, 4) + col; const float* g = p.g_mlp + l * 1024 + col;
        const float* xin = (l == 0 ? p.x : p.out) + (size_t)row * DM + col; float* xo = p.out + (size_t)row * DM + col; bf16_t* xn = (bf16_t*)(p.ws + WS_XN) + (size_t)row * DM + col;
#pragma unroll
        for (int i = 0; i < 4; ++i) { const float y = a[i] + (l == 1 ? p.swa_b_o[col + i] : 0.f); const float x1 = xin[i] + gt[i] * y; xo[i] = x1; xn[i] = (bf16_t)f2bf(x1 * (g[i] * (1.f + sc[i]))); }
    }
};
struct E5 { Params p; int l, pad;
    __device__ void operator()(int row, int col, const float* a) const {
        const int b = row / SEQ; const float r = rstd_x16(p, row); const float* bu = (const float*)(p.ws + WS_BIASU) + (l * 2 + b) * FF + col;
        bf16_t* o = (bf16_t*)(p.ws + WS_H) + (size_t)row * FF + col;
#pragma unroll
        for (int i = 0; i < 4; ++i) { const float v = fmaxf(r * a[i] + bu[i], 0.f); o[i] = (bf16_t)f2bf(v * v); }
    }
};
struct E6 { Params p; int l, pad;
    __device__ void operator()(int row, int col, const float* a) const {
        const int b = row / SEQ; const float* gt = modp(p, l, b, 5) + col; float* xo = p.out + (size_t)row * DM + col;
        float x2[4];
#pragma unroll
        for (int i = 0; i < 4; ++i) { x2[i] = xo[i] + gt[i] * a[i]; xo[i] = x2[i]; }
        if (l == 0) { const float* sc = modp(p, 1, b, 1) + col; const float* g = p.g_mix + 1024 + col; bf16_t* xn = (bf16_t*)(p.ws + WS_XN) + (size_t)row * DM + col;
#pragma unroll
            for (int i = 0; i < 4; ++i) xn[i] = (bf16_t)f2bf(x2[i] * (g[i] * (1.f + sc[i]))); }
    }
};
struct E7 { Params p;
    __device__ void operator()(int row, int col, const float* a) const {
        const int b = row / SEQ; const float r = rstd_x16(p, row); const float* bq = (const float*)(p.ws + WS_BIASQ) + b * 1536 + col;
        bf16_t* o; float sc = 1.f;
        if (col < 1024) { o = (bf16_t*)(p.ws + WS_Q1) + (size_t)row * 1024 + col; sc = C2_SWA; }
        else if (col < 1280) o = (bf16_t*)(p.ws + WS_K1) + (size_t)row * 256 + (col - 1024);
        else o = (bf16_t*)(p.ws + WS_V1) + (size_t)row * 256 + (col - 1280);
#pragma unroll
        for (int i = 0; i < 4; ++i) o[i] = (bf16_t)f2bf((r * a[i] + bq[i]) * sc);
    }
};
template <class Epi>
__global__ void __launch_bounds__(256) gemm(const bf16_t* A, const bf16_t* Wt, int lda, int N, int K, int pad, Epi E) {
    __shared__ float As[16][68], Ws[16][68];
    const int tx = threadIdx.x & 15, ty = threadIdx.x >> 4, row0 = blockIdx.y * 64, col0 = blockIdx.x * 64;
    float acc[4][4];
#pragma unroll
    for (int i = 0; i < 4; ++i)
#pragma unroll
        for (int j = 0; j < 4; ++j) acc[i][j] = 0.f;
    for (int k0 = 0; k0 < K; k0 += 16) {
#pragma unroll
        for (int i = 0; i < 4; ++i) { const int e = threadIdx.x + 256 * i, r = e >> 4, kk = e & 15;
            As[kk][r] = bf2f(A[(size_t)(row0 + r) * lda + k0 + kk]); Ws[kk][r] = bf2f(Wt[(size_t)(col0 + r) * K + k0 + kk]); }
        __syncthreads();
#pragma unroll
        for (int kk = 0; kk < 16; ++kk) { float a[4], w[4];
#pragma unroll
            for (int i = 0; i < 4; ++i) { a[i] = As[kk][ty * 4 + i]; w[i] = Ws[kk][tx * 4 + i]; }
#pragma unroll
            for (int i = 0; i < 4; ++i)
#pragma unroll
                for (int j = 0; j < 4; ++j) acc[i][j] += a[i] * w[j]; }
        __syncthreads();
    }
#pragma unroll
    for (int i = 0; i < 4; ++i) { float v[4] = {acc[i][0], acc[i][1], acc[i][2], acc[i][3]}; E(row0 + ty * 4 + i, col0 + tx * 4, v); }
}
template <bool SWA>
__global__ void __launch_bounds__(256) attn(Params p) {
    constexpr int DQ = SWA ? 64 : 192, DV = SWA ? 64 : 128, NQ = DQ / 64, NV = DV / 64, H = SWA ? SHQ : NHM;
    constexpr int QP = SWA ? 1024 : 1536, KP = SWA ? 256 : 1536, VP = SWA ? 256 : 1024;
    const int lane = threadIdx.x & 63; const long gid = (long)blockIdx.x * 4 + (threadIdx.x >> 6);
    const int q = (int)(gid % SEQ), h = (int)((gid / SEQ) % H), b = (int)(gid / ((long)SEQ * H));
    const bf16_t* Qr = (const bf16_t*)(p.ws + (SWA ? WS_Q1 : WS_Q)) + (size_t)(b * SEQ + q) * QP + h * DQ;
    const bf16_t* Kb = (const bf16_t*)(p.ws + (SWA ? WS_K1 : WS_K)) + (size_t)b * SEQ * KP + (SWA ? (h / 4) * 64 : h * 192);
    const bf16_t* Vb = (const bf16_t*)(p.ws + (SWA ? WS_V1 : WS_V)) + (size_t)b * SEQ * VP + (SWA ? (h / 4) * 64 : h * 128);
    bf16_t* Or = (bf16_t*)(p.ws + WS_O) + (size_t)(b * SEQ + q) * 1024 + h * DV;
    float qv[NQ];
#pragma unroll
    for (int i = 0; i < NQ; ++i) qv[i] = bf2f(Qr[lane + 64 * i]);
    const int jlo = SWA ? (q - (SWIN - 1) > 0 ? q - (SWIN - 1) : 0) : 0;
    const float slope2 = SWA ? exp2f(-0.5f * (float)(h + 1)) * LOG2E : 0.f;
    float m = SWA ? p.swa_sinks[h] * LOG2E : -1e30f, l = SWA ? 1.f : 0.f; float o[NV];
#pragma unroll
    for (int i = 0; i < NV; ++i) o[i] = 0.f;
    for (int j0 = jlo; j0 <= q; j0 += 64) {
        const int j = j0 + lane; const bool valid = j <= q; const int jc = valid ? j : q;
        const uint4* kr = (const uint4*)(Kb + (size_t)jc * KP); float s = 0.f;
#pragma unroll
        for (int c8 = 0; c8 < DQ / 8; ++c8) { const uint4 kk = kr[c8]; const unsigned w[4] = {kk.x, kk.y, kk.z, kk.w};
#pragma unroll
            for (int e = 0; e < 8; ++e) { const int d = c8 * 8 + e; const float qd = __uint_as_float(__builtin_amdgcn_readlane(__float_as_uint(qv[d / 64]), d % 64));
                const float kd = (e & 1) ? __uint_as_float(w[e >> 1] & 0xffff0000u) : __uint_as_float(w[e >> 1] << 16); s += qd * kd; } }
        if (SWA) s -= slope2 * (float)(q - j);
        if (!valid) s = -__builtin_inff();
        float mx = s;
        for (int t = 1; t < 64; t <<= 1) mx = fmaxf(mx, __shfl_xor(mx, t));
        const float mn = fmaxf(m, mx), alpha = exp2f(m - mn), pj = exp2f(s - mn);
        float ps = pj;
        for (int t = 1; t < 64; t <<= 1) ps += __shfl_xor(ps, t);
        l = l * alpha + ps; m = mn;
#pragma unroll
        for (int i = 0; i < NV; ++i) o[i] *= alpha;
        for (int jj = 0; jj < 64; ++jj) { const float pb = __shfl(pj, jj); int r = j0 + jj; r = r <= q ? r : q; const bf16_t* vr = Vb + (size_t)r * VP;
#pragma unroll
            for (int i = 0; i < NV; ++i) o[i] += pb * bf2f(vr[lane + 64 * i]); }
    }
    const float il = 1.f / l;
#pragma unroll
    for (int i = 0; i < NV; ++i) Or[lane + 64 * i] = (bf16_t)f2bf(o[i] * il);
}
}
namespace pg8 {
#define PG8_LAS __attribute__((address_space(3)))
typedef short bf16x8 __attribute__((ext_vector_type(8)));
typedef float f32x4 __attribute__((ext_vector_type(4)));
typedef unsigned u32x4 __attribute__((ext_vector_type(4)));
constexpr int BM = 256, BK = 64, HALF = 128, HTB = HALF * BK * 2  , STAGE_BYTES = 8 * HTB, NXCD = 8, WGM = 8;

__host__ __device__ __forceinline__ int lds_byte(int r, int c) { const int st = (r >> 4) * 2 + (c >> 5), rr = r & 15, cc = c & 31, ob = rr * 64 + cc * 2; return st * 1024 + (ob ^ (((ob >> 9) & 1) << 5)); }
__host__ __device__ __forceinline__ void stage_rc(int b, int& R, int& C) { const int st = b / 1024, sb = b % 1024, swz = sb ^ (((sb >> 9) & 1) << 5); R = (st >> 1) * 16 + swz / 64; C = (st & 1) * 32 + (swz % 64) / 2; }
__host__ __device__ __forceinline__ int perm32(int rho) { const int n = rho >> 4, i = rho & 15; return 8 * (i >> 2) + 4 * n + (i & 3); }

struct Unit { int pm, pn; };
struct Gemm { const bf16_t* A; const bf16_t* Bt; int lda, N, K; };

struct StaticOrder {
    int nM, nN, nwg, G, c;
    __host__ __device__ void init(int M_, int N, int G_, int c_) { nM = M_ / BM; nN = N / BM; nwg = nM * nN; G = G_; c = c_; }
    __host__ __device__ bool next(int i, Unit& u) const {
        const long L = (long)i * G + c; if (L >= nwg) return false;
        int wgid = (int)L; { const int q = nwg / NXCD, r = nwg % NXCD, xcd = wgid % NXCD, off = wgid / NXCD; wgid = (xcd < r ? xcd * (q + 1) : r * (q + 1) + (xcd - r) * q) + off; }
        const int nig = WGM * nN, gid = wgid / nig, fm = gid * WGM, gsz = (nM - fm) < WGM ? (nM - fm) : WGM;
        u.pm = fm + ((wgid % nig) % gsz); u.pn = (wgid % nig) / gsz; return true;
    }
};

__device__ __forceinline__ unsigned cvt_pk_bf16(float lo, float hi) { unsigned r; asm volatile("v_cvt_pk_bf16_f32 %0, %1, %2" : "=v"(r) : "v"(lo), "v"(hi)); return r; }
__device__ __forceinline__ u32x4 pack8(const f32x4& a, const f32x4& b) { u32x4 w; w.x = cvt_pk_bf16(a[0], a[1]); w.y = cvt_pk_bf16(a[2], a[3]); w.z = cvt_pk_bf16(b[0], b[1]); w.w = cvt_pk_bf16(b[2], b[3]); return w; }

template <class Epi, bool ALIGN_EPI>
__device__ __forceinline__ void gemm_phase(PG8_LAS unsigned char* lds, const Gemm g, const StaticOrder& S, const Epi& E) {
    int tid_ = threadIdx.x; asm volatile("" : "+v"(tid_));
    const int tid = tid_, wid = __builtin_amdgcn_readfirstlane(tid >> 6), lane = tid & 63, wr = wid >> 2, wc = wid & 3, fr = lane & 15, fq = lane >> 4;
    const int K = g.K, nt = K / BK, lda = g.lda;
    unsigned voffA[2], voffB[2];
#pragma unroll
    for (int i = 0; i < 2; ++i) { int R, C; stage_rc(tid * 16 + i * 8192, R, C); const int Rb = (R & ~31) + perm32(R & 31);
        voffA[i] = (unsigned)(R * lda + C) * 2u; voffB[i] = (unsigned)(Rb * K + C) * 2u; }
    const size_t kstep = (size_t)(BK * 2);
    const size_t hstepA = (size_t)HALF * lda * 2, hstepB = (size_t)HALF * K * 2;
    const size_t tstepA = 2 * hstepA, tstepB = 2 * hstepB;
    const unsigned ldsw = (unsigned)wid * 1024u;
    const int aoff = lds_byte(wr * 64 + fr, fq * 8), boff = lds_byte(wc * 32 + fr, fq * 8);
#define PG8_SA(b, h) (((b) * 2 + (h)) * HTB)
#define PG8_SB(b, h) ((4 + (b) * 2 + (h)) * HTB)
#define PG8_STAGE(bufoff, gbase, voff) do { _Pragma("unroll") for (int _i = 0; _i < 2; ++_i) \
        __builtin_amdgcn_global_load_lds((const unsigned*)((const char*)(gbase) + (voff)[_i]), (PG8_LAS unsigned*)(lds + (bufoff) + ldsw + _i * 8192), 16, 0, 0); } while (0)
#define PG8_LDA(dst, b, h) do { _Pragma("unroll") for (int m = 0; m < 4; ++m) _Pragma("unroll") for (int k = 0; k < 2; ++k) dst[m][k] = *(const PG8_LAS bf16x8*)(lds + PG8_SA(b, h) + aoff + m * 2048 + k * 1024); } while (0)
#define PG8_LDB(dst, b, h) do { _Pragma("unroll") for (int n = 0; n < 2; ++n) _Pragma("unroll") for (int k = 0; k < 2; ++k) dst[n][k] = *(const PG8_LAS bf16x8*)(lds + PG8_SB(b, h) + boff + n * 2048 + k * 1024); } while (0)
#define PG8_MMA(ai, bj, At, Bt) do { __builtin_amdgcn_s_setprio(1); _Pragma("unroll") for (int m = 0; m < 4; ++m) _Pragma("unroll") for (int n = 0; n < 2; ++n) _Pragma("unroll") for (int k = 0; k < 2; ++k) \
        acc[ai][bj][m][n] = __builtin_amdgcn_mfma_f32_16x16x32_bf16(Bt[n][k], At[m][k], acc[ai][bj][m][n], 0, 0, 0); __builtin_amdgcn_s_setprio(0); } while (0)
#define PG8_WAIT_V(n) asm volatile("s_waitcnt vmcnt(" #n ")" ::: "memory")
#define PG8_WAIT_L(n) asm volatile("s_waitcnt lgkmcnt(" #n ")" ::: "memory")
#define PG8_BAR __builtin_amdgcn_s_barrier()
#define PG8_SCHED __builtin_amdgcn_sched_barrier(0)
    Unit cur, nxt; int ui = 0;
    if (!S.next(0, cur)) return;
    f32x4 acc[2][2][4][2];
#pragma unroll
    for (int a = 0; a < 2; ++a)
#pragma unroll
        for (int b = 0; b < 2; ++b)
#pragma unroll
            for (int m = 0; m < 4; ++m)
#pragma unroll
                for (int n = 0; n < 2; ++n) acc[a][b][m][n] = (f32x4){0.f, 0.f, 0.f, 0.f};
    bf16x8 At[4][2], B0[2][2], B1[2][2];
    const char* cA = (const char*)g.A + (size_t)cur.pm * tstepA; const char* cB = (const char*)g.Bt + (size_t)cur.pn * tstepB;
    PG8_STAGE(PG8_SB(0, 0), cB, voffB); PG8_STAGE(PG8_SB(0, 1), cB + hstepB, voffB); PG8_STAGE(PG8_SA(0, 0), cA, voffA); PG8_STAGE(PG8_SA(0, 1), cA + hstepA, voffA);
    if (wr == 1) PG8_BAR;
    PG8_WAIT_V(2); PG8_BAR;
    PG8_STAGE(PG8_SB(1, 0), cB + kstep, voffB); PG8_STAGE(PG8_SA(1, 0), cA + kstep, voffA); PG8_STAGE(PG8_SB(1, 1), cB + hstepB + kstep, voffB);
    PG8_WAIT_V(6); PG8_BAR;
    for (;;) {
        const bool has_next = S.next(ui + 1, nxt);
        const char* nA = has_next ? (const char*)g.A + (size_t)nxt.pm * tstepA : cA; const char* nB = has_next ? (const char*)g.Bt + (size_t)nxt.pn * tstepB : cB;
        for (int t = 0; t < nt; t += 2) {
            const bool last = (t == nt - 2);
            const char* a1 = cA + (size_t)(t + 1) * kstep;
            const char* a2 = last ? nA : cA + (size_t)(t + 2) * kstep; const char* b2 = last ? nB : cB + (size_t)(t + 2) * kstep;
            const char* a3 = a2 + kstep; const char* b3 = b2 + kstep;
            PG8_LDB(B0, 0, 0); PG8_LDB(B1, 0, 1); PG8_SCHED; PG8_LDA(At, 0, 0); PG8_STAGE(PG8_SA(1, 1), a1 + hstepA, voffA);
            PG8_WAIT_V(8); PG8_WAIT_L(0); PG8_BAR; PG8_MMA(0, 0, At, B0); PG8_MMA(0, 1, At, B1); PG8_BAR; PG8_SCHED;
            PG8_LDA(At, 0, 1); PG8_STAGE(PG8_SB(0, 0), b2, voffB); PG8_STAGE(PG8_SB(0, 1), b2 + hstepB, voffB); PG8_STAGE(PG8_SA(0, 0), a2, voffA);
            PG8_WAIT_V(8); PG8_WAIT_L(0); PG8_BAR; PG8_MMA(1, 0, At, B0); PG8_MMA(1, 1, At, B1); PG8_BAR; PG8_SCHED;
            PG8_LDB(B0, 1, 0); PG8_LDB(B1, 1, 1); PG8_SCHED; PG8_LDA(At, 1, 0); PG8_STAGE(PG8_SA(0, 1), a2 + hstepA, voffA);
            PG8_WAIT_V(8); PG8_WAIT_L(0); PG8_BAR; PG8_MMA(0, 0, At, B0); PG8_MMA(0, 1, At, B1); PG8_BAR; PG8_SCHED;
            PG8_LDA(At, 1, 1); PG8_STAGE(PG8_SB(1, 0), b3, voffB); PG8_STAGE(PG8_SB(1, 1), b3 + hstepB, voffB); PG8_STAGE(PG8_SA(1, 0), a3, voffA);
            PG8_WAIT_V(8); PG8_WAIT_L(0); PG8_BAR; PG8_MMA(1, 0, At, B0); PG8_MMA(1, 1, At, B1); PG8_BAR; PG8_SCHED;
        }
        if constexpr (ALIGN_EPI) { if (wr == 0) PG8_BAR; }
        { int l2; asm volatile("v_mbcnt_lo_u32_b32 %0, -1, 0\n\tv_mbcnt_hi_u32_b32 %0, -1, %0" : "=v"(l2)); E(acc, cur, wr, wc, l2 & 15, l2 >> 4); }
        if (!has_next) break;
#pragma unroll
        for (int a = 0; a < 2; ++a)
#pragma unroll
            for (int b = 0; b < 2; ++b)
#pragma unroll
                for (int m = 0; m < 4; ++m)
#pragma unroll
                    for (int n = 0; n < 2; ++n) acc[a][b][m][n] = (f32x4){0.f, 0.f, 0.f, 0.f};
        cur = nxt; cA = nA; cB = nB; ++ui;
        if constexpr (ALIGN_EPI) { if (wr == 1) PG8_BAR; }
    }
    PG8_WAIT_V(0);
    if constexpr (!ALIGN_EPI) { if (wr == 0) PG8_BAR; }
    PG8_BAR;
#undef PG8_SA
#undef PG8_SB
#undef PG8_STAGE
#undef PG8_LDA
#undef PG8_LDB
#undef PG8_MMA
#undef PG8_WAIT_V
#undef PG8_WAIT_L
#undef PG8_BAR
#undef PG8_SCHED
}

typedef const f32x4 (&AccRef)[2][2][4][2];
__device__ __forceinline__ float sum4sq(const f32x4& v) { return (v[0] * v[0] + v[1] * v[1]) + (v[2] * v[2] + v[3] * v[3]); }
__device__ __forceinline__ float rstd16(const float* q, float invn) { const f32x4 a = *(const f32x4*)q, b = *(const f32x4*)(q + 4), c = *(const f32x4*)(q + 8), d = *(const f32x4*)(q + 12);
    const float s = ((a[0] + a[1]) + (a[2] + a[3])) + ((b[0] + b[1]) + (b[2] + b[3])) + ((c[0] + c[1]) + (c[2] + c[3])) + ((d[0] + d[1]) + (d[2] + d[3])); return __builtin_amdgcn_rsqf(s * invn + EPS); }
__device__ __forceinline__ void rope8(f32x4& v0, f32x4& v1, const float* cs) {
    const f32x4 c0 = *(const f32x4*)cs, c1 = *(const f32x4*)(cs + 4);
    f32x4 o0, o1;
    o0[0] = v0[0] * c0[0] - v0[1] * c0[1]; o0[1] = v0[0] * c0[1] + v0[1] * c0[0]; o0[2] = v0[2] * c0[2] - v0[3] * c0[3]; o0[3] = v0[2] * c0[3] + v0[3] * c0[2];
    o1[0] = v1[0] * c1[0] - v1[1] * c1[1]; o1[1] = v1[0] * c1[1] + v1[1] * c1[0]; o1[2] = v1[2] * c1[2] - v1[3] * c1[3]; o1[3] = v1[2] * c1[3] + v1[3] * c1[2];
    v0 = o0; v1 = o1;
}
struct EpiDown { unsigned char* ws;
    __device__ __forceinline__ void operator()(AccRef acc, const Unit& u, int wr, int wc, int fr, int fq) const {
        const int row0 = u.pm * BM + wr * 64 + fr, b = u.pm >> 5, cb = u.pn * BM + wc * 32 + 8 * fq;
        const float* bd = (const float*)(ws + WS_BIASD) + b * ND + cb; f32x4 bv[2][2];
#pragma unroll
        for (int bj = 0; bj < 2; ++bj)
#pragma unroll
            for (int n = 0; n < 2; ++n) bv[bj][n] = *(const f32x4*)(bd + bj * HALF + 4 * n);
#pragma unroll
        for (int ai = 0; ai < 2; ++ai)
#pragma unroll
            for (int m = 0; m < 4; ++m) { int row = row0 + ai * HALF + m * 16; asm volatile("" : "+v"(row)); const float r = ((const float*)(ws + WS_RSTDX))[row];
#pragma unroll
                for (int bj = 0; bj < 2; ++bj) { const int c8 = cb + bj * HALF; f32x4 v0 = acc[ai][bj][m][0] * r + bv[bj][0], v1 = acc[ai][bj][m][1] * r + bv[bj][1];
                    if (c8 < 640) { *(u32x4*)((bf16_t*)(ws + WS_RAW) + (size_t)row * ND + c8) = pack8(v0, v1);
                        float ss = sum4sq(v0) + sum4sq(v1); ss += __shfl_xor(ss, 16); ss += __shfl_xor(ss, 32);
                        if (fq == 0) ((float*)(ws + WS_SSQ1))[(size_t)row * 24 + u.pn * 8 + bj * 4 + wc] = ss; }
                    else if (c8 < 704) { const int j = c8 - 640; rope8(v0, v1, (const float*)(ws + WS_ROPE) + ((size_t)row * 32 + (j >> 1)) * 2); const u32x4 w = pack8(v0, v1);
                        bf16_t* kp = (bf16_t*)(ws + WS_K) + (size_t)row * 1536 + 128 + j;
#pragma unroll
                        for (int h = 0; h < NHM; ++h) *(u32x4*)(kp + h * 192) = w; } }
                asm volatile("" ::: "memory"); }
    }
};
struct EpiQ { unsigned char* ws;
    __device__ __forceinline__ void operator()(AccRef acc, const Unit& u, int wr, int wc, int fr, int fq) const {
        const int row0 = u.pm * BM + wr * 64 + fr, cb = u.pn * BM + wc * 32 + 8 * fq;
#pragma unroll
        for (int ai = 0; ai < 2; ++ai)
#pragma unroll
            for (int m = 0; m < 4; ++m) { int row = row0 + ai * HALF + m * 16; asm volatile("" : "+v"(row)); const float* q = (const float*)(ws + WS_SSQ1) + (size_t)row * 24;
                const f32x4 a = *(const f32x4*)q, bb = *(const f32x4*)(q + 4), c = *(const f32x4*)(q + 8);
                const float r = __builtin_amdgcn_rsqf((((a[0] + a[1]) + (a[2] + a[3])) + ((bb[0] + bb[1]) + (bb[2] + bb[3])) + ((c[0] + c[1]) + (c[2] + c[3]))) * (1.f / QL) + EPS);
#pragma unroll
                for (int bj = 0; bj < 2; ++bj) { const int c8 = cb + bj * HALF; f32x4 v0 = acc[ai][bj][m][0] * r, v1 = acc[ai][bj][m][1] * r;
                    if ((4 * u.pn + 2 * bj + (wc >> 1)) % 3 == 2) rope8(v0, v1, (const float*)(ws + WS_ROPE) + ((size_t)row * 32 + (((wc & 1) * 32 + 8 * fq) >> 1)) * 2);
                    v0 = v0 * C2_MLA; v1 = v1 * C2_MLA;
                    *(u32x4*)((bf16_t*)(ws + WS_Q) + (size_t)row * 1536 + c8) = pack8(v0, v1); }
                asm volatile("" ::: "memory"); }
    }
};
struct EpiKV { unsigned char* ws;
    __device__ __forceinline__ void operator()(AccRef acc, const Unit& u, int wr, int wc, int fr, int fq) const {
        const int row0 = u.pm * BM + wr * 64 + fr, cw = wc * 32 + 8 * fq;
#pragma unroll
        for (int ai = 0; ai < 2; ++ai)
#pragma unroll
            for (int m = 0; m < 4; ++m) { int row = row0 + ai * HALF + m * 16; asm volatile("" : "+v"(row)); const float* q = (const float*)(ws + WS_SSQ1) + (size_t)row * 24 + 12;
                const f32x4 a = *(const f32x4*)q, bb = *(const f32x4*)(q + 4);
                const float r = __builtin_amdgcn_rsqf((((a[0] + a[1]) + (a[2] + a[3])) + ((bb[0] + bb[1]) + (bb[2] + bb[3]))) * (1.f / KVL) + EPS);
                *(u32x4*)((bf16_t*)(ws + WS_K) + (size_t)row * 1536 + u.pn * 192 + cw) = pack8(acc[ai][0][m][0] * r, acc[ai][0][m][1] * r);
                *(u32x4*)((bf16_t*)(ws + WS_V) + (size_t)row * 1024 + u.pn * 128 + cw) = pack8(acc[ai][1][m][0] * r, acc[ai][1][m][1] * r);
                asm volatile("" ::: "memory"); }
    }
};
struct EpiRes { const float* xin; float* xout; const float* gate; const float* bo; const float* g; const float* sc; unsigned char* ws;
    __device__ __forceinline__ void operator()(AccRef acc, const Unit& u, int wr, int wc, int fr, int fq) const {
        const int row0 = u.pm * BM + wr * 64 + fr, b = u.pm >> 5, cb = u.pn * BM + wc * 32 + 8 * fq;
        const float* gtp = gate + b * 6144 + cb; const float* scp = sc ? sc + b * 6144 + cb : nullptr;
#pragma unroll
        for (int ai = 0; ai < 2; ++ai)
#pragma unroll
            for (int m = 0; m < 4; ++m) { int row = row0 + ai * HALF + m * 16; asm volatile("" : "+v"(row)); float ss = 0.f;
#pragma unroll
                for (int bj = 0; bj < 2; ++bj) { const int cj = bj * HALF; const size_t off = (size_t)row * DM + cb + cj;
                    f32x4 y0 = acc[ai][bj][m][0], y1 = acc[ai][bj][m][1];
                    if (bo) { y0 = y0 + *(const f32x4*)(bo + cb + cj); y1 = y1 + *(const f32x4*)(bo + cb + cj + 4); }
                    const f32x4 x0 = *(const f32x4*)(xin + off) + *(const f32x4*)(gtp + cj) * y0, x1 = *(const f32x4*)(xin + off + 4) + *(const f32x4*)(gtp + cj + 4) * y1;
                    *(f32x4*)(xout + off) = x0; *(f32x4*)(xout + off + 4) = x1; ss += sum4sq(x0) + sum4sq(x1);
                    if (g) { const f32x4 g0 = *(const f32x4*)(g + cb + cj) * (*(const f32x4*)(scp + cj) + 1.f), g1 = *(const f32x4*)(g + cb + cj + 4) * (*(const f32x4*)(scp + cj + 4) + 1.f);
                        *(u32x4*)((bf16_t*)(ws + WS_XN) + off) = pack8(x0 * g0, x1 * g1); } }
                ss += __shfl_xor(ss, 16); ss += __shfl_xor(ss, 32);
                if (fq == 0) ((float*)(ws + WS_SSQX))[(size_t)row * 16 + u.pn * 4 + wc] = ss;
                asm volatile("" ::: "memory"); }
    }
};
struct EpiUp { const float* biasu; unsigned char* ws;
    __device__ __forceinline__ void operator()(AccRef acc, const Unit& u, int wr, int wc, int fr, int fq) const {
        const int row0 = u.pm * BM + wr * 64 + fr, b = u.pm >> 5, cb = u.pn * BM + wc * 32 + 8 * fq; f32x4 bv[2][2];
#pragma unroll
        for (int bj = 0; bj < 2; ++bj)
#pragma unroll
            for (int n = 0; n < 2; ++n) bv[bj][n] = *(const f32x4*)(biasu + b * FF + cb + bj * HALF + 4 * n);
#pragma unroll
        for (int ai = 0; ai < 2; ++ai)
#pragma unroll
            for (int m = 0; m < 4; ++m) { int row = row0 + ai * HALF + m * 16; asm volatile("" : "+v"(row)); const float r = rstd16((const float*)(ws + WS_SSQX) + (size_t)row * 16, 1.f / DM);
#pragma unroll
                for (int bj = 0; bj < 2; ++bj) { f32x4 v0 = acc[ai][bj][m][0] * r + bv[bj][0], v1 = acc[ai][bj][m][1] * r + bv[bj][1];
#pragma unroll
                    for (int i = 0; i < 4; ++i) { v0[i] = fmaxf(v0[i], 0.f); v1[i] = fmaxf(v1[i], 0.f); }
                    *(u32x4*)((bf16_t*)(ws + WS_H) + (size_t)row * FF + cb + bj * HALF) = pack8(v0 * v0, v1 * v1); }
                if (m & 1) asm volatile("" ::: "memory"); }
    }
};
struct EpiQKV1 { unsigned char* ws;
    __device__ __forceinline__ void operator()(AccRef acc, const Unit& u, int wr, int wc, int fr, int fq) const {
        const int row0 = u.pm * BM + wr * 64 + fr, b = u.pm >> 5, cw = wc * 32 + 8 * fq, cb = u.pn * BM + cw; f32x4 bv[2][2];
#pragma unroll
        for (int bj = 0; bj < 2; ++bj)
#pragma unroll
            for (int n = 0; n < 2; ++n) bv[bj][n] = *(const f32x4*)((const float*)(ws + WS_BIASQ) + b * 1536 + cb + bj * HALF + 4 * n);
        bf16_t* base; int ld; float sc = 1.f;
        if (u.pn < 4) { base = (bf16_t*)(ws + WS_Q1) + cb; ld = 1024; sc = C2_SWA; } else if (u.pn == 4) { base = (bf16_t*)(ws + WS_K1) + cw; ld = 256; } else { base = (bf16_t*)(ws + WS_V1) + cw; ld = 256; }
#pragma unroll
        for (int ai = 0; ai < 2; ++ai)
#pragma unroll
            for (int m = 0; m < 4; ++m) { int row = row0 + ai * HALF + m * 16; asm volatile("" : "+v"(row)); const float r = rstd16((const float*)(ws + WS_SSQX) + (size_t)row * 16, 1.f / DM);
#pragma unroll
                for (int bj = 0; bj < 2; ++bj) *(u32x4*)(base + (size_t)row * ld + bj * HALF) = pack8((acc[ai][bj][m][0] * r + bv[bj][0]) * sc, (acc[ai][bj][m][1] * r + bv[bj][1]) * sc);
                if (m & 1) asm volatile("" ::: "memory"); }
    }
};
}
constexpr int NWAVES = 8;
constexpr int N_PHASES = 14;
constexpr int CW_TMO = 0, CW_CODE = 1;
constexpr int CW_BAR = 4096;
constexpr int RING_OFF = 0, RING_BYTES = 131072;
constexpr int LDSCTL_OFF = RING_BYTES, MISC_OFF = LDSCTL_OFF + 320;
constexpr int LDS_BYTES = 147456;
#define GAS __attribute__((address_space(1)))
#define LAS __attribute__((address_space(3)))
typedef unsigned v4u __attribute__((ext_vector_type(4)));
typedef float f32x4 __attribute__((ext_vector_type(4)));
typedef GAS unsigned gu32;
#define RLX_AGENT __ATOMIC_RELAXED, __HIP_MEMORY_SCOPE_AGENT
#define LDS_WAIT() asm volatile("s_waitcnt lgkmcnt(0)" ::: "memory")
#define VM_WAIT() asm volatile("s_waitcnt vmcnt(0)" ::: "memory")

#define XB_TMO      128
#define XB_XCNT(j)  (256  + 64 * (j))
#define XB_XSUB(j)  (1280 + 64 * (j))
#define XB_XGEN(j)  (2304 + 64 * (j))
#define XB_TOP      3328
#define XB_TOPGEN   3392
#define XCD_BAR_WORDS 3456
#define XB_SPIN_CAP (1u << 18)
__device__ __forceinline__ unsigned xb_ld(unsigned* p)              { return __hip_atomic_load(p, __ATOMIC_RELAXED, __HIP_MEMORY_SCOPE_AGENT); }
__device__ __forceinline__ unsigned xb_add(unsigned* p, unsigned v) { return __hip_atomic_fetch_add(p, v, __ATOMIC_RELAXED, __HIP_MEMORY_SCOPE_AGENT); }
__device__ __forceinline__ unsigned xb_xcc_id() { return (unsigned)__builtin_amdgcn_s_getreg((3 << 11) | 20) & 0xFu; }
#define XB_SPIN(cond, bar) do { unsigned _sp = 0; while (cond) { __builtin_amdgcn_s_sleep(1); \
    if ((++_sp & 255u) == 0u) { if (xb_ld(&(bar)[XB_TMO])) break; if (_sp > XB_SPIN_CAP) { atomicAdd(&(bar)[XB_TMO], 1u); break; } } } } while (0)
struct XcdBarrier { unsigned* bar; unsigned x; volatile LAS unsigned* st; };
__device__ __forceinline__ XcdBarrier xcd_barrier_post(unsigned* bar, volatile LAS unsigned* st) {
    XcdBarrier b; b.bar = bar; b.x = xb_xcc_id(); b.st = st;
    if (threadIdx.x == 0) (void)xb_add(&bar[XB_XCNT(b.x)], 1u);
    return b;
}
__device__ __forceinline__ void xcd_barrier_complete(unsigned* bar, unsigned x, unsigned& nloc, unsigned& nx) {
    const unsigned G = gridDim.x * gridDim.y * gridDim.z;
    unsigned sum, cnt, mine, sp = 0u;
    for (;;) {
        sum = 0u; cnt = 0u; mine = 0u;
#pragma unroll
        for (unsigned j = 0; j < 16; ++j) { const unsigned c = xb_ld(&bar[XB_XCNT(j)]); sum += c; cnt += (c > 0u) ? 1u : 0u; mine = (j == x) ? c : mine; }
        if (sum == G) break;
        __builtin_amdgcn_s_sleep(1);
        if ((++sp & 255u) == 0u) { if (xb_ld(&bar[XB_TMO])) break; if (sp > XB_SPIN_CAP) { atomicAdd(&bar[XB_TMO], 1u); break; } }
    }
    nloc = mine > 0u ? mine : 1u; nx = cnt > 0u ? cnt : 1u;
}
__device__ __forceinline__ void xcd_barrier(const XcdBarrier& b) {
    asm volatile("s_waitcnt vmcnt(0)" ::: "memory");
    __syncthreads();
    if (threadIdx.x == 0) {
        unsigned* bar = b.bar;
        __builtin_amdgcn_s_waitcnt(0);
        unsigned nloc = b.st[0], nx = b.st[1];
        if (nloc == 0u) { xcd_barrier_complete(bar, b.x, nloc, nx); b.st[0] = nloc; b.st[1] = nx; }
        const unsigned old = xb_add(&bar[XB_XSUB(b.x)], 1u);
        const unsigned gen = old / nloc;
        if (old + 1u == (gen + 1u) * nloc) {
            __builtin_amdgcn_fence(__ATOMIC_RELEASE, "agent");
            asm volatile("s_waitcnt vmcnt(0)" ::: "memory");
            const unsigned og = xb_add(&bar[XB_TOP], 1u);
            const unsigned tg = og / nx;
            if (og + 1u == (tg + 1u) * nx) xb_add(&bar[XB_TOPGEN], 1u);
            else XB_SPIN(xb_ld(&bar[XB_TOPGEN]) == tg, bar);
            __builtin_amdgcn_fence(__ATOMIC_ACQUIRE, "agent");
            xb_add(&bar[XB_XGEN(b.x)], 1u);
            asm volatile("s_waitcnt vmcnt(0)" ::: "memory");
        } else {
            XB_SPIN(xb_ld(&bar[XB_XGEN(b.x)]) == gen, bar);
            __builtin_amdgcn_fence(__ATOMIC_ACQUIRE, "agent");
            asm volatile("s_waitcnt vmcnt(0)" ::: "memory");
        }
    }
    __syncthreads();
}

__device__ __forceinline__ float wave_sum(float v) {
#pragma unroll
    for (int o = 1; o < 64; o <<= 1) v += __shfl_xor(v, o);
    return v;
}
struct Frame { LAS unsigned char* lds; int tid, lane, wave, vcu, G; };

__device__ __forceinline__ void p0_transpose_item(const Params& p, int id, LAS float* scr, int item, int lane) {
    const int N = w_N(id), K = w_K(id); bf16_t* WT = (bf16_t*)(p.ws + w_off(id));
    const int nblk = N / 32, kb = item / nblk, nb = item % nblk, k0 = 64 * kb, n0 = 32 * nb;
#pragma unroll 4
    for (int i = 0; i < 32; ++i) { const int kk = 2 * i + (lane >> 5); scr[kk * 33 + (lane & 31)] = wsrc(p, id, k0 + kk, n0 + (lane & 31)); }
    LDS_WAIT(); asm volatile("" ::: "memory");
    const int c = lane & 7;
#pragma unroll
    for (int j = 0; j < 4; ++j) { const int n = (lane >> 3) + 8 * j; const LAS float* s = scr + (8 * c) * 33 + n;
        v4u o; o.x = pk2(s[0 * 33], s[1 * 33]); o.y = pk2(s[2 * 33], s[3 * 33]); o.z = pk2(s[4 * 33], s[5 * 33]); o.w = pk2(s[6 * 33], s[7 * 33]);
        *(GAS v4u*)(WT + (size_t)(n0 + n) * K + k0 + 8 * c) = o; }
    LDS_WAIT(); asm volatile("" ::: "memory");
}
template <class VF, class WF> __device__ __forceinline__ float wg_gemv64(Frame& F, int n0, VF vec, WF wfn) {
    LAS float* red = (LAS float*)(F.lds + RING_OFF);
    float a0 = 0.f, a1 = 0.f; const int kb = F.wave * 128;
#pragma unroll 8
    for (int k = 0; k < 128; ++k) { const float w = wfn(kb + k, n0 + F.lane); a0 += vec(0, kb + k) * w; a1 += vec(1, kb + k) * w; }
    red[(F.wave * 2 + 0) * 64 + F.lane] = a0; red[(F.wave * 2 + 1) * 64 + F.lane] = a1;
    __syncthreads();
    float s = 0.f;
    if (F.wave < 2) {
#pragma unroll
        for (int w = 0; w < 8; ++w) s += red[(w * 2 + F.wave) * 64 + F.lane]; }
    __syncthreads();
    return s;
}
__device__ __forceinline__ void p0a(Frame& F, const Params& p) {
    if (F.vcu < 192) { const int l = F.vcu / 96, n0 = (F.vcu % 96) * 64; const float* wa = p.w_ada + (size_t)l * 1024 * 6144;
        const float s = wg_gemv64(F, n0, [&](int b, int k) { const float cv = p.c[b * 1024 + k]; return cv / (1.f + __expf(-cv)); }, [&](int k, int n) { return wa[(size_t)k * 6144 + n]; });
        if (F.wave < 2) ((float*)(p.ws + WS_MOD))[(l * 2 + F.wave) * 6144 + n0 + F.lane] = s + p.b_ada[l * 6144 + n0 + F.lane]; }
    for (int e = F.vcu * 512 + F.tid; e < M * 32; e += F.G * 512) { const int row = e >> 5, i = e & 31; const float inv = powf(10000.f, -(float)i / 32.f); const float ang = (float)p.pos[row] * inv;
        float* r = (float*)(p.ws + WS_ROPE) + (size_t)e * 2; r[0] = cosf(ang); r[1] = sinf(ang); }
    LAS float* scr = (LAS float*)(F.lds + RING_OFF + 8192 + F.wave * 12288);
    const int gw = F.vcu * NWAVES + F.wave, NGW = F.G * NWAVES;
    constexpr int NI_TOTAL = 384 + 288 + 256 + 512 + 2048 + 2048 + 768 + 512 + 2048 + 2048;
    for (int it = gw; it < NI_TOTAL; it += NGW) { int r = it, id = 0;
#pragma unroll 1
        for (; id < 9; ++id) { const int ni = (w_K(id) / 64) * (w_N(id) / 32); if (r < ni) break; r -= ni; }
        p0_transpose_item(p, id, scr, r, F.lane); }
}
__device__ __forceinline__ void p0b(Frame& F, const Params& p) {
    if (F.vcu < 164) { int it = F.vcu; int wid, l, hp, n0; float* dst; const float* addb = nullptr;
        if (it < 12) { wid = 0; l = 0; hp = 0; n0 = it * 64; dst = (float*)(p.ws + WS_BIASD); }
        else if (it < 140) { it -= 12; l = it / 64; wid = l == 0 ? 4 : 8; hp = 3; n0 = (it % 64) * 64; dst = (float*)(p.ws + WS_BIASU) + l * 2 * FF; }
        else { it -= 140; wid = 6; l = 1; hp = 0; n0 = it * 64; dst = (float*)(p.ws + WS_BIASQ); addb = p.swa_b_qkv; }
        const int N = w_N(wid); const float* sh0 = modp(p, l, 0, hp);
        const float s = wg_gemv64(F, n0, [&](int b, int k) { return sh0[b * 6144 + k]; }, [&](int k, int n) { return wsrc(p, wid, k, n); });
        if (F.wave < 2) dst[F.wave * N + n0 + F.lane] = s + (addb ? addb[n0 + F.lane] : 0.f); }
    const int gw = F.vcu * NWAVES + F.wave, NGW = F.G * NWAVES;
    for (int m = gw; m < M; m += NGW) { const int b = m / SEQ;
        const GAS f32x4* xr = (const GAS f32x4*)(p.x + (size_t)m * DM) + F.lane; const f32x4* gm = (const f32x4*)p.g_mix + F.lane; const f32x4* sc = (const f32x4*)modp(p, 0, b, 1) + F.lane;
        f32x4 v[4]; float s = 0.f;
#pragma unroll
        for (int j = 0; j < 4; ++j) { v[j] = xr[64 * j]; s += (v[j].x * v[j].x + v[j].y * v[j].y) + (v[j].z * v[j].z + v[j].w * v[j].w); }
        s = wave_sum(s);
        if (F.lane == 0) ((float*)(p.ws + WS_RSTDX))[m] = 1.f / sqrtf(s * (1.f / DM) + EPS);
        GAS unsigned long long* o8 = (GAS unsigned long long*)((bf16_t*)(p.ws + WS_XN) + (size_t)m * DM) + F.lane;
#pragma unroll
        for (int j = 0; j < 4; ++j) { const f32x4 gs = gm[64 * j] * (sc[64 * j] + 1.f); const f32x4 o = v[j] * gs;
            o8[64 * j] = (unsigned long long)pk2(o.x, o.y) | ((unsigned long long)pk2(o.z, o.w) << 32); } }
}
__device__ __forceinline__ void p_final(Frame& F, const Params& p) {
    const int gw = F.vcu * NWAVES + F.wave, NGW = F.G * NWAVES;
    for (int m = gw; m < M; m += NGW) { const float r = pg8::rstd16((const float*)(p.ws + WS_SSQX) + (size_t)m * 16, 1.f / DM);
        GAS f32x4* xr = (GAS f32x4*)(p.out + (size_t)m * DM) + F.lane; const f32x4* gf = (const f32x4*)p.g_final + F.lane;
#pragma unroll
        for (int j = 0; j < 4; ++j) xr[64 * j] = xr[64 * j] * r * gf[64 * j]; }
}
namespace att {
typedef short bf16x8 __attribute__((ext_vector_type(8)));
typedef short s16x4 __attribute__((ext_vector_type(4)));
typedef float f32x16 __attribute__((ext_vector_type(16)));
typedef unsigned u32x4 __attribute__((ext_vector_type(4)));
#define ATT_SBAR() __builtin_amdgcn_sched_barrier(0)
__device__ __forceinline__ int crow(int r, int hi) { return (r & 3) + 8 * (r >> 2) + 4 * hi; }
__device__ __forceinline__ unsigned cvtpk(float lo, float hi) { unsigned r; asm volatile("v_cvt_pk_bf16_f32 %0, %1, %2" : "=v"(r) : "v"(lo), "v"(hi)); return r; }
template <int NC> __device__ __forceinline__ int v_st(int k, int c) { const int kk = (k & ~0xC) | ((k & 4) << 1) | ((k & 8) >> 1); return ((kk >> 3) * (NC / 32) + (c >> 5)) * 512 + ((kk & 7) * 32 + (c & 31)) * 2; }
__device__ __forceinline__ int v_rd_base(int lane) { return ((lane & 3) << 3) | (((lane >> 2) & 3) << 6) | (((lane >> 4) & 1) << 5) | (((lane >> 5) & 1) << 8); }
__device__ __forceinline__ float rowmax32(const f32x16& p0, const f32x16& p1) {
    float m = p0[0];
#pragma unroll
    for (int r = 1; r < 16; ++r) m = fmaxf(m, p0[r]);
#pragma unroll
    for (int r = 0; r < 16; ++r) m = fmaxf(m, p1[r]);
    auto rr = __builtin_amdgcn_permlane32_swap(__float_as_uint(m), __float_as_uint(m), false, false);
    return fmaxf(__uint_as_float(rr[0]), __uint_as_float(rr[1]));
}
__device__ __forceinline__ float softmax_tile(f32x16& p0, f32x16& p1, float& m_reg, float& l_reg, bf16x8& pa0, bf16x8& pa1, bf16x8& pa2, bf16x8& pa3) {
    const float pmax = rowmax32(p0, p1);
    const float mn = fmaxf(m_reg, pmax); const float alpha = __builtin_amdgcn_exp2f(m_reg - mn); m_reg = mn;
#pragma unroll
    for (int r = 0; r < 16; ++r) { p0[r] = __builtin_amdgcn_exp2f(p0[r] - mn); p1[r] = __builtin_amdgcn_exp2f(p1[r] - mn); }
    float ps = 0.f;
#pragma unroll
    for (int r = 0; r < 16; ++r) ps += p0[r];
#pragma unroll
    for (int r = 0; r < 16; ++r) ps += p1[r];
    { auto rr = __builtin_amdgcn_permlane32_swap(__float_as_uint(ps), __float_as_uint(ps), false, false); ps = __uint_as_float(rr[0]) + __uint_as_float(rr[1]); }
    l_reg = l_reg * alpha + ps;
#define ATT_PK4(P, B_, OUT) do { unsigned a0 = cvtpk(P[B_+0], P[B_+1]), a1 = cvtpk(P[B_+2], P[B_+3]); unsigned b0 = cvtpk(P[B_+4], P[B_+5]), b1 = cvtpk(P[B_+6], P[B_+7]); \
        auto r0 = __builtin_amdgcn_permlane32_swap(a0, b0, false, false); auto r1 = __builtin_amdgcn_permlane32_swap(a1, b1, false, false); \
        u32x4 w = {r0[0], r1[0], r0[1], r1[1]}; OUT = __builtin_bit_cast(bf16x8, w); } while (0)
    ATT_PK4(p0, 0, pa0); ATT_PK4(p0, 8, pa1); ATT_PK4(p1, 0, pa2); ATT_PK4(p1, 8, pa3);
#undef ATT_PK4
    return alpha;
}
#define ATT_TRRD(dst, off) asm volatile("ds_read_b64_tr_b16 %0, %1 offset:%2" : "=&v"(dst) : "v"(vb0), "i"(off) : "memory")
#define ATT_FRAG(l, h) (bf16x8){l[0], l[1], l[2], l[3], h[0], h[1], h[2], h[3]}

namespace mla {
constexpr int KROW = 400, SHM_K = 64 * KROW, SHM_V = 16384, OFF_V = 0, OFF_K = 2 * SHM_V, OFF_WS = OFF_K + 2 * SHM_K, LDS_NEED = OFF_WS + 8 * 256;
template <int VB> __device__ __forceinline__ void pv_tile(f32x16* o, int vb0, bf16x8 pa0, bf16x8 pa1, bf16x8 pa2, bf16x8 pa3) {
#define MLA_PV_D0(d0) do { s16x4 l0, l1, l2, l3, h0, h1, h2, h3; constexpr int b_ = OFF_V + VB * SHM_V + (d0) * 512;     \
        ATT_TRRD(l0, b_); ATT_TRRD(h0, b_ + 2048); ATT_TRRD(l1, b_ + 4096); ATT_TRRD(h1, b_ + 6144); ATT_TRRD(l2, b_ + 8192); ATT_TRRD(h2, b_ + 10240); ATT_TRRD(l3, b_ + 12288); ATT_TRRD(h3, b_ + 14336); \
        asm volatile("s_waitcnt lgkmcnt(0)" ::: "memory"); ATT_SBAR(); \
        o[d0] = __builtin_amdgcn_mfma_f32_32x32x16_bf16(pa0, ATT_FRAG(l0, h0), o[d0], 0, 0, 0); o[d0] = __builtin_amdgcn_mfma_f32_32x32x16_bf16(pa1, ATT_FRAG(l1, h1), o[d0], 0, 0, 0); \
        o[d0] = __builtin_amdgcn_mfma_f32_32x32x16_bf16(pa2, ATT_FRAG(l2, h2), o[d0], 0, 0, 0); o[d0] = __builtin_amdgcn_mfma_f32_32x32x16_bf16(pa3, ATT_FRAG(l3, h3), o[d0], 0, 0, 0); } while (0)
    MLA_PV_D0(0); MLA_PV_D0(1); MLA_PV_D0(2); MLA_PV_D0(3);
#undef MLA_PV_D0
}
template <int KB> __device__ __forceinline__ void qkt(f32x16& p0, f32x16& p1, LAS unsigned char* lds, int r32, int hi, const bf16x8* qr) {
    p0 = f32x16{}; p1 = f32x16{};
    const LAS unsigned char* kb = lds + OFF_K + KB * SHM_K + r32 * KROW + hi * 16;
#pragma unroll
    for (int d0 = 0; d0 < 12; ++d0) { const bf16x8 b0 = *(const LAS bf16x8*)(kb + d0 * 32), b1 = *(const LAS bf16x8*)(kb + d0 * 32 + 32 * KROW);
        p0 = __builtin_amdgcn_mfma_f32_32x32x16_bf16(b0, qr[d0], p0, 0, 0, 0); p1 = __builtin_amdgcn_mfma_f32_32x32x16_bf16(b1, qr[d0], p1, 0, 0, 0); }
}
__device__ __forceinline__ void unit(int b, int h, int qb, unsigned char* ws, LAS unsigned char* lds) {
    int tid_ = threadIdx.x; asm volatile("" : "+v"(tid_));
    const int tid = tid_, wid = __builtin_amdgcn_readfirstlane(tid >> 6), lane = tid & 63, r32 = lane & 31, hi = lane >> 5;
    const size_t rowbase = (size_t)b * SEQ; const int q0 = qb * 256, q0w = q0 + wid * 32;
    const bf16_t* Kh = (const bf16_t*)(ws + WS_K) + rowbase * 1536 + h * 192; const bf16_t* Vh = (const bf16_t*)(ws + WS_V) + rowbase * 1024 + h * 128;
    bf16x8 qr[12];
    { const bf16_t* Qw = (const bf16_t*)(ws + WS_Q) + (rowbase + q0w + r32) * 1536 + h * 192 + hi * 8;
#pragma unroll
      for (int d0 = 0; d0 < 12; ++d0) qr[d0] = *(const bf16x8*)(Qw + d0 * 16); }
    int kgo[3], klo[3];
#pragma unroll
    for (int i = 0; i < 3; ++i) { const int e = tid + 512 * i, row = e / 24, ch = e % 24; kgo[i] = row * 1536 + ch * 8; klo[i] = row * KROW + ch * 16; }
    const int sr = tid >> 4, sc = (tid & 15) * 8, vgo = sr * 1024 + sc, vst0 = v_st<128>(sr, sc), vst1 = v_st<128>(32 + sr, sc);
    const int vb0 = (int)(uintptr_t)(lds + OFF_V) + v_rd_base(lane);
    LAS float* wsf = (LAS float*)(lds + OFF_WS) + wid * 64;
    const int NT = 4 * (qb + 1);
    bf16x8 sk0, sk1, sk2, sv0, sv1;
#define MLA_LOAD(t) do { const bf16_t* kp = Kh + (size_t)(t) * 64 * 1536; const bf16_t* vp = Vh + (size_t)(t) * 64 * 1024; \
        sk0 = *(const bf16x8*)(kp + kgo[0]); sk1 = *(const bf16x8*)(kp + kgo[1]); sk2 = *(const bf16x8*)(kp + kgo[2]); sv0 = *(const bf16x8*)(vp + vgo); sv1 = *(const bf16x8*)(vp + vgo + 32 * 1024); } while (0)
#define MLA_WRITE(B) do { LAS unsigned char* kd = lds + OFF_K + (B) * SHM_K; LAS unsigned char* vd = lds + OFF_V + (B) * SHM_V; \
        *(LAS bf16x8*)(kd + klo[0]) = sk0; *(LAS bf16x8*)(kd + klo[1]) = sk1; *(LAS bf16x8*)(kd + klo[2]) = sk2; *(LAS bf16x8*)(vd + vst0) = sv0; *(LAS bf16x8*)(vd + vst1) = sv1; } while (0)
    float m_reg = -1e30f, l_reg = 0.f; f32x16 o[4] = {};
    MLA_LOAD(0); MLA_WRITE(0); MLA_LOAD(1);
    __syncthreads();
#define MLA_STEP(t, B) do { \
        if ((t) + 1 < NT) { MLA_WRITE((B) ^ 1); } \
        if ((t) + 2 < NT) { MLA_LOAD((t) + 2); } \
        ATT_SBAR(); \
        f32x16 p0, p1; qkt<B>(p0, p1, lds, r32, hi, qr); \
        if (64 * (t) + 63 > q0w) { const int dq = q0w + r32 - 64 * (t) - 4 * hi; const float NEG = -__builtin_inff(); \
            _Pragma("unroll") for (int r = 0; r < 16; ++r) { const int c = (r & 3) + 8 * (r >> 2); if (c > dq) p0[r] = NEG; if (c + 32 > dq) p1[r] = NEG; } } \
        bf16x8 pa0, pa1, pa2, pa3; const float alpha = softmax_tile(p0, p1, m_reg, l_reg, pa0, pa1, pa2, pa3); \
        if (__any(alpha < 1.f)) { if (hi == 0) wsf[r32] = alpha; asm volatile("s_waitcnt lgkmcnt(0)" ::: "memory"); \
            _Pragma("unroll") for (int d_ = 0; d_ < 4; ++d_) _Pragma("unroll") for (int r = 0; r < 16; ++r) o[d_][r] *= wsf[crow(r, hi)]; } \
        ATT_SBAR(); pv_tile<B>(o, vb0, pa0, pa1, pa2, pa3); \
        __syncthreads(); } while (0)
    for (int t = 0; t < NT; t += 2) { MLA_STEP(t, 0); MLA_STEP(t + 1, 1); }
#undef MLA_STEP
#undef MLA_LOAD
#undef MLA_WRITE
    if (hi == 0) wsf[32 + r32] = l_reg; asm volatile("s_waitcnt lgkmcnt(0)" ::: "memory");
    bf16_t* Ow = (bf16_t*)(ws + WS_O) + (rowbase + q0w) * 1024 + h * 128;
#pragma unroll
    for (int r = 0; r < 16; ++r) { const int orow = crow(r, hi); const float rl = __builtin_amdgcn_rcpf(wsf[32 + orow]);
#pragma unroll
        for (int d0 = 0; d0 < 4; ++d0) { const float v = o[d0][r] * rl; const float vn = __shfl_xor(v, 1);
            if ((r32 & 1) == 0) *(unsigned*)(Ow + (size_t)orow * 1024 + d0 * 32 + r32) = cvtpk(v, vn); } }
    __syncthreads();
}
__device__ __forceinline__ void phase(int vcu, unsigned char* ws, LAS unsigned char* lds) {
    const int bh = vcu >> 4, s = vcu & 15;
    if (bh >= BATCH * NHM) return;
    unit(bh >> 3, bh & 7, 31 - s, ws, lds);
    unit(bh >> 3, bh & 7, s, ws, lds);
}
}

namespace swa {
constexpr int KROW = 144, SHM_K = 64 * KROW, SHM_V = 8192, OFF_V = 0, OFF_K = 3 * SHM_V, OFF_WS = OFF_K + 3 * SHM_K, LDS_NEED = OFF_WS + 8 * 256;
template <int T> __device__ __forceinline__ void tile(f32x16* o, float& m_reg, float& l_reg, const bf16x8* qr, LAS unsigned char* lds, LAS float* wsf, int vb0, int r32, int hi, int qpos, int kbase, unsigned weff, float slope2) {
    constexpr int t = T;
    f32x16 p0 = {}, p1 = {};
    { const LAS unsigned char* kb = lds + OFF_K + t * SHM_K + r32 * KROW + hi * 16;
#pragma unroll
      for (int d0 = 0; d0 < 4; ++d0) { const bf16x8 b0 = *(const LAS bf16x8*)(kb + d0 * 32), b1 = *(const LAS bf16x8*)(kb + d0 * 32 + 32 * KROW);
          p0 = __builtin_amdgcn_mfma_f32_32x32x16_bf16(b0, qr[d0], p0, 0, 0, 0); p1 = __builtin_amdgcn_mfma_f32_32x32x16_bf16(b1, qr[d0], p1, 0, 0, 0); } }
    { const int dq = qpos - (kbase + 64 * t) - 4 * hi; const float NEG = -__builtin_inff();
#pragma unroll
      for (int r = 0; r < 16; ++r) { const int c = (r & 3) + 8 * (r >> 2); const int d0_ = dq - c, d1_ = dq - c - 32;
          p0[r] = (unsigned)d0_ < weff ? p0[r] - slope2 * (float)d0_ : NEG; p1[r] = (unsigned)d1_ < weff ? p1[r] - slope2 * (float)d1_ : NEG; } }
    bf16x8 pa0, pa1, pa2, pa3; const float alpha = softmax_tile(p0, p1, m_reg, l_reg, pa0, pa1, pa2, pa3);
    if (__any(alpha < 1.f)) { if (hi == 0) wsf[r32] = alpha; asm volatile("s_waitcnt lgkmcnt(0)" ::: "memory");
#pragma unroll
        for (int d_ = 0; d_ < 2; ++d_)
#pragma unroll
            for (int r = 0; r < 16; ++r) o[d_][r] *= wsf[crow(r, hi)]; }
    ATT_SBAR();
#define SWA_PV_D0(d0) do { s16x4 l0, l1, l2, l3, h0, h1, h2, h3; constexpr int b_ = OFF_V + t * SHM_V + (d0) * 512;     \
    ATT_TRRD(l0, b_); ATT_TRRD(h0, b_ + 1024); ATT_TRRD(l1, b_ + 2048); ATT_TRRD(h1, b_ + 3072); ATT_TRRD(l2, b_ + 4096); ATT_TRRD(h2, b_ + 5120); ATT_TRRD(l3, b_ + 6144); ATT_TRRD(h3, b_ + 7168); \
    asm volatile("s_waitcnt lgkmcnt(0)" ::: "memory"); ATT_SBAR(); \
    o[d0] = __builtin_amdgcn_mfma_f32_32x32x16_bf16(pa0, ATT_FRAG(l0, h0), o[d0], 0, 0, 0); o[d0] = __builtin_amdgcn_mfma_f32_32x32x16_bf16(pa1, ATT_FRAG(l1, h1), o[d0], 0, 0, 0); \
    o[d0] = __builtin_amdgcn_mfma_f32_32x32x16_bf16(pa2, ATT_FRAG(l2, h2), o[d0], 0, 0, 0); o[d0] = __builtin_amdgcn_mfma_f32_32x32x16_bf16(pa3, ATT_FRAG(l3, h3), o[d0], 0, 0, 0); } while (0)
    SWA_PV_D0(0); SWA_PV_D0(1);
#undef SWA_PV_D0
}
__device__ __forceinline__ void unit(int b, int kvh, int qblk, unsigned char* ws, const float* sinks, LAS unsigned char* lds) {
    int tid_ = threadIdx.x; asm volatile("" : "+v"(tid_));
    const int tid = tid_, wid = __builtin_amdgcn_readfirstlane(tid >> 6), lane = tid & 63, r32 = lane & 31, hi = lane >> 5;
    const size_t rowbase = (size_t)b * SEQ; const int q0 = qblk * 64, q0w = q0 + (wid & 1) * 32, hq = kvh * 4 + (wid >> 1), kbase = q0 - 128;
    const bf16_t* Kh = (const bf16_t*)(ws + WS_K1) + rowbase * 256 + kvh * 64; const bf16_t* Vh = (const bf16_t*)(ws + WS_V1) + rowbase * 256 + kvh * 64;
#pragma unroll
    for (int i = 0; i < 3; ++i) { const int e = tid + 512 * i, row = e >> 3, ch = e & 7; int key = kbase + row; key = key < 0 ? 0 : key;
        const bf16x8 kv = *(const bf16x8*)(Kh + (size_t)key * 256 + ch * 8), vv = *(const bf16x8*)(Vh + (size_t)key * 256 + ch * 8);
        *(LAS bf16x8*)(lds + OFF_K + row * KROW + ch * 16) = kv; *(LAS bf16x8*)(lds + OFF_V + (row >> 6) * SHM_V + v_st<64>(row & 63, ch * 8)) = vv; }
    bf16x8 qr[4];
    { const bf16_t* Qw = (const bf16_t*)(ws + WS_Q1) + (rowbase + q0w + r32) * 1024 + hq * 64 + hi * 8;
#pragma unroll
      for (int d0 = 0; d0 < 4; ++d0) qr[d0] = *(const bf16x8*)(Qw + d0 * 16); }
    const int vb0 = (int)(uintptr_t)(lds + OFF_V) + v_rd_base(lane);
    LAS float* wsf = (LAS float*)(lds + OFF_WS) + wid * 64;
    const float slope2 = __builtin_amdgcn_exp2f(-0.5f * (float)(hq + 1)) * LOG2E;
    float m_reg = sinks[hq] * LOG2E, l_reg = 1.f; f32x16 o[2] = {};
    const int qpos = q0w + r32; const unsigned weff = (unsigned)(qpos + 1 < SWIN ? qpos + 1 : SWIN);
    __syncthreads();
    tile<0>(o, m_reg, l_reg, qr, lds, wsf, vb0, r32, hi, qpos, kbase, weff, slope2); tile<1>(o, m_reg, l_reg, qr, lds, wsf, vb0, r32, hi, qpos, kbase, weff, slope2); tile<2>(o, m_reg, l_reg, qr, lds, wsf, vb0, r32, hi, qpos, kbase, weff, slope2);
    if (hi == 0) wsf[32 + r32] = l_reg; asm volatile("s_waitcnt lgkmcnt(0)" ::: "memory");
    bf16_t* Ow = (bf16_t*)(ws + WS_O) + (rowbase + q0w) * 1024 + hq * 64;
#pragma unroll
    for (int r = 0; r < 16; ++r) { const int orow = crow(r, hi); const float rl = __builtin_amdgcn_rcpf(wsf[32 + orow]);
#pragma unroll
        for (int d0 = 0; d0 < 2; ++d0) { const float v = o[d0][r] * rl; const float vn = __shfl_xor(v, 1);
            if ((r32 & 1) == 0) *(unsigned*)(Ow + (size_t)orow * 1024 + d0 * 32 + r32) = cvtpk(v, vn); } }
    __syncthreads();
}
__device__ __forceinline__ void phase(int vcu, int G, unsigned char* ws, const float* sinks, LAS unsigned char* lds) {
    for (int u = vcu; u < BATCH * SHK * (SEQ / 64); u += G) { const int bk = u >> 7; unit(bk >> 2, bk & 3, u & 127, ws, sinks, lds); }
}
}
}
#define FAST_ATTN_MLA() do { unsigned char* ws_ = ld_params(ka).ws; att::mla::phase(F.vcu, ws_, F.lds + RING_OFF); } while (0)
#define FAST_ATTN_SWA() do { const Params p_ = ld_params(ka); att::swa::phase(F.vcu, F.G, p_.ws, p_.swa_sinks, F.lds + RING_OFF); } while (0)
struct Args { Params p; int ph_lo, ph_hi, li, pad; };
typedef const __attribute__((address_space(4))) Args* KArgs;
__device__ __forceinline__ Params ld_params(KArgs ka) { asm volatile("" : "+s"(ka)); Params p;
    const __attribute__((address_space(4))) unsigned long long* s = (const __attribute__((address_space(4))) unsigned long long*)ka; unsigned long long* d = (unsigned long long*)&p;
#pragma unroll
    for (int i = 0; i < (int)(sizeof(Params) / 8); ++i) d[i] = s[i];
    return p; }
__global__ void __launch_bounds__(NWAVES * 64, 2) mega(Args args) {
    extern __shared__ __attribute__((aligned(16))) unsigned char lds[];
    KArgs ka = (KArgs)__builtin_amdgcn_kernarg_segment_ptr();
    Frame F;
    F.lds = (LAS unsigned char*)lds;
    volatile LAS unsigned* MISC = (volatile LAS unsigned*)(F.lds + MISC_OFF);
    F.tid = threadIdx.x; F.lane = F.tid & 63; F.wave = __builtin_amdgcn_readfirstlane(F.tid >> 6);
#define REFRESH_F() do { int t_ = threadIdx.x; asm volatile("" : "+v"(t_)); F.tid = t_; F.lane = t_ & 63; } while (0)
    F.G = gridDim.x; { const int bx = blockIdx.x; F.vcu = (F.G % 8 == 0) ? (bx % 8) * (F.G / 8) + bx / 8 : bx; }
    for (int u = F.tid; u < (LDS_BYTES - LDSCTL_OFF) / 4; u += NWAVES * 64) ((LAS unsigned*)(F.lds + LDSCTL_OFF))[u] = 0u;
    __syncthreads();
    const int lo = args.ph_lo, hi = args.ph_hi;
    XcdBarrier bar = xcd_barrier_post((unsigned*)(ld_params(ka).ws + WS_CTL) + CW_BAR + args.li * XCD_BAR_WORDS, MISC + 8);
#ifndef PHASE_ON
#define PHASE_ON(k) true
#endif
#define IN(k) (PHASE_ON(k) && lo <= (k) && (k) < hi)
#define SEAM(k) do { if (IN(k) && IN((k) + 1)) xcd_barrier(bar); } while (0)
    if (IN(0)) { const Params p = ld_params(ka); REFRESH_F(); p0a(F, p); SEAM(0); }
    if (IN(1)) { const Params p = ld_params(ka); REFRESH_F(); p0b(F, p); SEAM(1); }
    if (IN(2)) { unsigned char* ws = ld_params(ka).ws; pg8::Gemm g{(const bf16_t*)(ws + WS_XN), (const bf16_t*)(ws + WS_WD), 1024, ND, 1024}; pg8::StaticOrder S; S.init(M, ND, F.G, (int)blockIdx.x);
        pg8::gemm_phase<pg8::EpiDown, false>(F.lds + RING_OFF, g, S, pg8::EpiDown{ws}); SEAM(2); }
    if (IN(3)) {
        { unsigned char* ws = ld_params(ka).ws; pg8::Gemm g{(const bf16_t*)(ws + WS_RAW), (const bf16_t*)(ws + WS_WUQ), ND, 1536, QL}; pg8::StaticOrder S; S.init(M, 1536, F.G, (int)blockIdx.x);
          pg8::gemm_phase<pg8::EpiQ, true>(F.lds + RING_OFF, g, S, pg8::EpiQ{ws}); }
        { unsigned char* ws = ld_params(ka).ws; pg8::Gemm g{(const bf16_t*)(ws + WS_RAW) + 384, (const bf16_t*)(ws + WS_WUKV), ND, 2048, KVL}; pg8::StaticOrder S; S.init(M, 2048, F.G, (int)(F.G - 1 - blockIdx.x));
          pg8::gemm_phase<pg8::EpiKV, true>(F.lds + RING_OFF, g, S, pg8::EpiKV{ws}); }
        SEAM(3); }
    if (IN(4)) { FAST_ATTN_MLA(); SEAM(4); }
#pragma unroll 1
    for (int l = 0; l < 2; ++l) {
        const int pb = l == 0 ? 5 : 10;
        if (IN(pb)) { const Params p = ld_params(ka); unsigned char* ws = p.ws;
            pg8::Gemm g{(const bf16_t*)(ws + WS_O), (const bf16_t*)(ws + (l == 0 ? WS_WO0 : WS_WO1)), 1024, 1024, 1024}; pg8::StaticOrder S; S.init(M, 1024, F.G, (int)blockIdx.x);
            pg8::EpiRes E{l == 0 ? p.x : p.out, p.out, modp(p, l, 0, 2), l == 0 ? nullptr : p.swa_b_o, p.g_mlp + l * 1024, modp(p, l, 0, 4), ws};
            pg8::gemm_phase<pg8::EpiRes, false>(F.lds + RING_OFF, g, S, E); SEAM(pb); }
        if (IN(pb + 1)) { unsigned char* ws = ld_params(ka).ws;
            pg8::Gemm g{(const bf16_t*)(ws + WS_XN), (const bf16_t*)(ws + (l == 0 ? WS_W10 : WS_W11)), 1024, FF, 1024}; pg8::StaticOrder S; S.init(M, FF, F.G, (int)blockIdx.x);
            pg8::EpiUp E{(const float*)(ws + WS_BIASU) + l * 2 * FF, ws};
            pg8::gemm_phase<pg8::EpiUp, true>(F.lds + RING_OFF, g, S, E); SEAM(pb + 1); }
        if (IN(pb + 2)) { const Params p = ld_params(ka); unsigned char* ws = p.ws;
            pg8::Gemm g{(const bf16_t*)(ws + WS_H), (const bf16_t*)(ws + (l == 0 ? WS_W20 : WS_W21)), FF, 1024, FF}; pg8::StaticOrder S; S.init(M, 1024, F.G, (int)blockIdx.x);
            pg8::EpiRes E{p.out, p.out, modp(p, l, 0, 5), nullptr, l == 0 ? p.g_mix + 1024 : nullptr, l == 0 ? modp(p, 1, 0, 1) : nullptr, ws};
            pg8::gemm_phase<pg8::EpiRes, false>(F.lds + RING_OFF, g, S, E); SEAM(pb + 2); }
        if (l == 0) {
            if (IN(8)) { unsigned char* ws = ld_params(ka).ws; pg8::Gemm g{(const bf16_t*)(ws + WS_XN), (const bf16_t*)(ws + WS_WQKV), 1024, 1536, 1024}; pg8::StaticOrder S; S.init(M, 1536, F.G, (int)blockIdx.x);
                pg8::gemm_phase<pg8::EpiQKV1, true>(F.lds + RING_OFF, g, S, pg8::EpiQKV1{ws}); SEAM(8); }
            if (IN(9)) { FAST_ATTN_SWA(); SEAM(9); }
        }
    }
    if (IN(13)) { const Params p = ld_params(ka); REFRESH_F(); p_final(F, p); }
#undef IN
#undef SEAM
}

static Params make_params(void* const* d_in, void* d_out, void* d_ws) {
    Params p{};
    p.x = (const float*)d_in[0]; p.c = (const float*)d_in[1]; p.pos = (const int*)d_in[2];
    p.w_ada = (const float*)d_in[3]; p.b_ada = (const float*)d_in[4]; p.g_mix = (const float*)d_in[5]; p.g_mlp = (const float*)d_in[6];
    p.w_dq = (const float*)d_in[7]; p.g_q = (const float*)d_in[8]; p.w_uq = (const float*)d_in[9]; p.w_dkv = (const float*)d_in[10];
    p.g_kv = (const float*)d_in[11]; p.w_ukv = (const float*)d_in[12]; p.mla_w_o = (const float*)d_in[13];
    p.swa_w_qkv = (const float*)d_in[14]; p.swa_b_qkv = (const float*)d_in[15]; p.swa_sinks = (const float*)d_in[16];
    p.swa_w_o = (const float*)d_in[17]; p.swa_b_o = (const float*)d_in[18]; p.w_ff1 = (const float*)d_in[19]; p.w_ff2 = (const float*)d_in[20];
    p.g_final = (const float*)d_in[21];
    p.out = (float*)d_out; p.ws = (unsigned char*)d_ws;
    return p;
}
#ifndef NO_NAIVE
template <class E> static void ngemm(hipStream_t st, const Params& p, size_t a_off, int lda, int wid, E e) {
    nv::gemm<E><<<dim3(w_N(wid) / 64, M / 64), 256, 0, st>>>((const bf16_t*)(p.ws + a_off), (const bf16_t*)(p.ws + w_off(wid)), lda, w_N(wid), w_K(wid), 0, e);
}
static void naive_phase(int ph, const Params& p, hipStream_t stream) {
    switch (ph) {
    case 0: for (int id = 0; id < 10; ++id) nv::wconv<<<(unsigned)(((size_t)w_N(id) * w_K(id) + 255) / 256), 256, 0, stream>>>(p, id, 0);
            nv::mod<<<96, 256, 0, stream>>>(p); nv::rope<<<M * 32 / 256, 256, 0, stream>>>(p); break;
    case 1: nv::bias<<<82, 256, 0, stream>>>(p); nv::prep0<<<M / 4, 256, 0, stream>>>(p); break;
    case 2: ngemm(stream, p, WS_XN, 1024, 0, nv::E1{p}); nv::ssq1<<<M / 4, 256, 0, stream>>>(p); break;
    case 3: ngemm(stream, p, WS_RAW, ND, 1, nv::E2q{p}); ngemm(stream, p, WS_RAW + 384 * 2, ND, 2, nv::E2kv{p}); break;
    case 4: nv::attn<false><<<BATCH * NHM * SEQ / 4, 256, 0, stream>>>(p); break;
    case 5: ngemm(stream, p, WS_O, 1024, 3, nv::E4{p, 0, 0}); nv::ssqx<<<M / 4, 256, 0, stream>>>(p); break;
    case 6: ngemm(stream, p, WS_XN, 1024, 4, nv::E5{p, 0, 0}); break;
    case 7: ngemm(stream, p, WS_H, FF, 5, nv::E6{p, 0, 0}); nv::ssqx<<<M / 4, 256, 0, stream>>>(p); break;
    case 8: ngemm(stream, p, WS_XN, 1024, 6, nv::E7{p}); break;
    case 9: nv::attn<true><<<BATCH * SHQ * SEQ / 4, 256, 0, stream>>>(p); break;
    case 10: ngemm(stream, p, WS_O, 1024, 7, nv::E4{p, 1, 0}); nv::ssqx<<<M / 4, 256, 0, stream>>>(p); break;
    case 11: ngemm(stream, p, WS_XN, 1024, 8, nv::E5{p, 1, 0}); break;
    case 12: ngemm(stream, p, WS_H, FF, 9, nv::E6{p, 1, 0}); nv::ssqx<<<M / 4, 256, 0, stream>>>(p); break;
    default: nv::final_norm<<<M / 4, 256, 0, stream>>>(p); break;
    }
}
#endif
extern "C" void kernel_launch(void* const* d_in, const int* in_sizes, int n_in, void* d_out, int out_size, void* d_ws, size_t ws_size, hipStream_t stream) {
    static int grid = 0;
    if (grid == 0) {
        if (n_in != 22 || in_sizes[0] != M * DM || out_size != M * DM || ws_size < WS_END) {
            fprintf(stderr, "kernel_launch: unexpected shapes (n_in %d, in0 %d, out %d, ws %zu)\n", n_in, n_in > 0 ? in_sizes[0] : -1, out_size, ws_size); grid = -1; return; }
        int dev = 0, cus = 0, per_cu = 0;
        if (hipGetDevice(&dev) != hipSuccess || hipDeviceGetAttribute(&cus, hipDeviceAttributeMultiprocessorCount, dev) != hipSuccess) { grid = -1; return; }
        if (hipFuncSetAttribute((const void*)mega, hipFuncAttributeMaxDynamicSharedMemorySize, LDS_BYTES) != hipSuccess) { fprintf(stderr, "kernel_launch: hipFuncSetAttribute failed\n"); grid = -1; return; }
        if (hipOccupancyMaxActiveBlocksPerMultiprocessor(&per_cu, (const void*)mega, NWAVES * 64, LDS_BYTES) != hipSuccess || per_cu < 1)
            fprintf(stderr, "kernel_launch: note: occupancy query reports %d workgroups per CU\n", per_cu);
        (void)hipGetLastError();
        grid = cus;
    }
    if (grid < 0) return;
    const Params p = make_params(d_in, d_out, d_ws);
    (void)hipMemsetAsync((char*)d_ws + WS_CTL, 0, CTL_ZERO_BYTES, stream);
    static const bool FAST[N_PHASES] = FAST_PHASES;
    int li = 0, i = 0;
    while (i < N_PHASES) {
        if (FAST[i]) { int j = i; while (j < N_PHASES && FAST[j]) ++j;
            Args a{}; a.p = p; a.ph_lo = i; a.ph_hi = j; a.li = li++;
            hipLaunchKernelGGL(mega, dim3(grid), dim3(NWAVES * 64), LDS_BYTES, stream, a);
            i = j; }
        else {
#ifndef NO_NAIVE
            naive_phase(i, p, stream);
#endif
            ++i; }
    }
}
```

```cpp
#include <hip/hip_runtime.h>
#include <cstdio>
#include <cstdint>

typedef unsigned short bf16_t;
constexpr int BATCH = 2, SEQ = 8192, DM = 1024, M = BATCH * SEQ, FF = 4096;
constexpr int QL = 384, KVL = 256, NHM = 8, QKD = 192, VDM = 128;
constexpr int ND = 768;
constexpr int SHQ = 16, SHK = 4, SHD = 64, SWIN = 128;
constexpr float EPS = 1e-6f;
constexpr float LOG2E = 1.4426950408889634f;
constexpr float C2_MLA = 0.07216878364870322f * LOG2E;
constexpr float C2_SWA = 0.125f * LOG2E;

constexpr size_t MiB = 1u << 20;
constexpr size_t WS_CTL = 0, CTL_ZERO_BYTES = 1 * MiB;
constexpr size_t WS_MOD = 1 * MiB;
constexpr size_t WS_BIASD = WS_MOD + 2 * 2 * 6144 * 4;
constexpr size_t WS_BIASU = WS_BIASD + 2 * ND * 4;
constexpr size_t WS_BIASQ = WS_BIASU + 2 * 2 * FF * 4;
constexpr size_t WS_RSTDX = WS_BIASQ + 2 * 1536 * 4;
static_assert(WS_RSTDX + (size_t)M * 4 <= 2 * MiB, "small arrays");
constexpr size_t WS_SSQ1 = 2 * MiB;
constexpr size_t WS_SSQX = 4 * MiB;
constexpr size_t WS_ROPE = 5 * MiB;
constexpr size_t WS_WD = 9 * MiB, WS_WUQ = 11 * MiB, WS_WUKV = 13 * MiB, WS_WO0 = 14 * MiB, WS_W10 = 16 * MiB, WS_W20 = 24 * MiB,
                 WS_WQKV = 32 * MiB, WS_WO1 = 35 * MiB, WS_W11 = 37 * MiB, WS_W21 = 45 * MiB;
constexpr size_t WS_XN = 53 * MiB;
constexpr size_t WS_RAW = 85 * MiB;
constexpr size_t WS_O = 85 * MiB;
constexpr size_t WS_Q = 117 * MiB;
constexpr size_t WS_K = 165 * MiB;
constexpr size_t WS_V = 213 * MiB;
constexpr size_t WS_H = 85 * MiB;
constexpr size_t WS_Q1 = 117 * MiB, WS_K1 = 149 * MiB, WS_V1 = 157 * MiB;
constexpr size_t WS_END = 245 * MiB;

struct Params {
    const float *x, *c; const int* pos;
    const float *w_ada, *b_ada, *g_mix, *g_mlp, *w_dq, *g_q, *w_uq, *w_dkv, *g_kv, *w_ukv, *mla_w_o;
    const float *swa_w_qkv, *swa_b_qkv, *swa_sinks, *swa_w_o, *swa_b_o, *w_ff1, *w_ff2, *g_final;
    float* out; unsigned char* ws;
};

__device__ __forceinline__ float bf2f(bf16_t u) { return __uint_as_float((unsigned)u << 16); }
__device__ __forceinline__ unsigned f2bf(float f) { unsigned u = __float_as_uint(f); return (u + 0x7fffu + ((u >> 16) & 1u)) >> 16; }
__device__ __forceinline__ unsigned pk2(float lo, float hi) { return f2bf(lo) | (f2bf(hi) << 16); }

__host__ __device__ constexpr int w_N(int id) { return id == 0 ? ND : id == 1 ? 1536 : id == 2 ? 2048 : id == 3 ? 1024 : id == 4 ? FF : id == 5 ? 1024 : id == 6 ? 1536 : id == 7 ? 1024 : id == 8 ? FF : 1024; }
__host__ __device__ constexpr int w_K(int id) { return id == 0 ? 1024 : id == 1 ? QL : id == 2 ? KVL : id == 3 ? 1024 : id == 4 ? 1024 : id == 5 ? FF : id == 6 ? 1024 : id == 7 ? 1024 : id == 8 ? 1024 : FF; }
__host__ __device__ constexpr size_t w_off(int id) { return id == 0 ? WS_WD : id == 1 ? WS_WUQ : id == 2 ? WS_WUKV : id == 3 ? WS_WO0 : id == 4 ? WS_W10 : id == 5 ? WS_W20 : id == 6 ? WS_WQKV : id == 7 ? WS_WO1 : id == 8 ? WS_W11 : WS_W21; }

__device__ __forceinline__ int rope_src(int j) { return (j >> 1) + 32 * (j & 1); }

__device__ __forceinline__ float wsrc(const Params& p, int id, int k, int n) {
    switch (id) {
    case 0: if (n < 384) return p.w_dq[(size_t)k * 384 + n];
            if (n < 640) return p.w_dkv[(size_t)k * 320 + (n - 384)];
            if (n < 704) return p.w_dkv[(size_t)k * 320 + 256 + rope_src(n - 640)];
            return 0.f;
    case 1: { const int h = n / 192, cc = n % 192; const int src = cc < 128 ? n : h * 192 + 128 + rope_src(cc - 128); return p.g_q[k] * p.w_uq[(size_t)k * 1536 + src]; }
    case 2: return p.g_kv[k] * p.w_ukv[(size_t)k * 2048 + n];
    case 3: return p.mla_w_o[(size_t)k * 1024 + n];
    case 4: return p.w_ff1[(size_t)k * FF + n];
    case 5: return p.w_ff2[(size_t)k * 1024 + n];
    case 6: return p.swa_w_qkv[(size_t)k * 1536 + n];
    case 7: return p.swa_w_o[(size_t)k * 1024 + n];
    case 8: return p.w_ff1[(size_t)1024 * FF + (size_t)k * FF + n];
    default: return p.w_ff2[(size_t)FF * 1024 + (size_t)k * 1024 + n];
    }
}
__device__ __forceinline__ const float* modp(const Params& p, int l, int b, int part) { return (const float*)(p.ws + WS_MOD) + ((l * 2 + b) * 6 + part) * 1024; }
#define FAST_PHASES {1,1,1,1,1,1,1,1,1,1,1,1,1,1}
namespace nv {
__global__ void __launch_bounds__(256) wconv(Params p, int id, int pad) {
    const int N = w_N(id), K = w_K(id); const size_t e = (size_t)blockIdx.x * 256 + threadIdx.x;
    if (e >= (size_t)N * K) return;
    const int n = (int)(e / K), k = (int)(e % K);
    ((bf16_t*)(p.ws + w_off(id)))[e] = (bf16_t)f2bf(wsrc(p, id, k, n));
}
__global__ void __launch_bounds__(256) mod(Params p) {
    const int t = blockIdx.x * 256 + threadIdx.x; if (t >= 2 * 2 * 6144) return;
    const int n = t % 6144, b = (t / 6144) % 2, l = t / (2 * 6144);
    float s = 0.f;
    for (int k = 0; k < 1024; ++k) { const float cv = p.c[b * 1024 + k]; const float cond = cv / (1.f + __expf(-cv)); s += cond * p.w_ada[((size_t)l * 1024 + k) * 6144 + n]; }
    ((float*)(p.ws + WS_MOD))[(l * 2 + b) * 6144 + n] = s + p.b_ada[l * 6144 + n];
}
__global__ void __launch_bounds__(256) bias(Params p) {
    const int t = blockIdx.x * 256 + threadIdx.x;
    if (t < 2 * ND) { const int b = t / ND, n = t % ND; const float* sh = modp(p, 0, b, 0); float s = 0.f; for (int k = 0; k < 1024; ++k) s += sh[k] * wsrc(p, 0, k, n);
        ((float*)(p.ws + WS_BIASD))[t] = s; return; }
    int u = t - 2 * ND;
    if (u < 2 * 2 * FF) { const int n = u % FF, b = (u / FF) % 2, l = u / (2 * FF); const float* sh = modp(p, l, b, 3); float s = 0.f; for (int k = 0; k < 1024; ++k) s += sh[k] * wsrc(p, l == 0 ? 4 : 8, k, n);
        ((float*)(p.ws + WS_BIASU))[u] = s; return; }
    u -= 2 * 2 * FF;
    if (u < 2 * 1536) { const int b = u / 1536, n = u % 1536; const float* sh = modp(p, 1, b, 0); float s = 0.f; for (int k = 0; k < 1024; ++k) s += sh[k] * wsrc(p, 6, k, n);
        ((float*)(p.ws + WS_BIASQ))[u] = s + p.swa_b_qkv[n]; }
}
__global__ void __launch_bounds__(256) prep0(Params p) {
    const int lane = threadIdx.x & 63, row = blockIdx.x * 4 + (threadIdx.x >> 6), b = row / SEQ;
    const float* xr = p.x + (size_t)row * DM; float s = 0.f;
    for (int i = lane; i < DM; i += 64) s += xr[i] * xr[i];
    for (int o = 1; o < 64; o <<= 1) s += __shfl_xor(s, o);
    if (lane == 0) ((float*)(p.ws + WS_RSTDX))[row] = 1.f / sqrtf(s * (1.f / DM) + EPS);
    const float* sc = modp(p, 0, b, 1); bf16_t* xn = (bf16_t*)(p.ws + WS_XN) + (size_t)row * DM;
    for (int i = lane; i < DM; i += 64) xn[i] = (bf16_t)f2bf(xr[i] * (p.g_mix[i] * (1.f + sc[i])));
}
__global__ void __launch_bounds__(256) rope(Params p) {
    const int e = blockIdx.x * 256 + threadIdx.x, row = e >> 5, i = e & 31;
    const float inv = powf(10000.f, -(float)i / 32.f); const float ang = (float)p.pos[row] * inv;
    float* r = (float*)(p.ws + WS_ROPE) + (size_t)e * 2; r[0] = cosf(ang); r[1] = sinf(ang);
}
__global__ void __launch_bounds__(256) ssq1(Params p) {
    const int lane = threadIdx.x & 63, row = blockIdx.x * 4 + (threadIdx.x >> 6);
    const bf16_t* r = (const bf16_t*)(p.ws + WS_RAW) + (size_t)row * ND; float a = 0.f, c = 0.f;
    for (int i = lane; i < 384; i += 64) { const float v = bf2f(r[i]); a += v * v; }
    for (int i = 384 + lane; i < 640; i += 64) { const float v = bf2f(r[i]); c += v * v; }
    for (int o = 1; o < 64; o <<= 1) { a += __shfl_xor(a, o); c += __shfl_xor(c, o); }
    float* q = (float*)(p.ws + WS_SSQ1) + (size_t)row * 24;
    if (lane < 24) q[lane] = lane == 0 ? a : lane == 12 ? c : 0.f;
}
__global__ void __launch_bounds__(256) ssqx(Params p) {
    const int lane = threadIdx.x & 63, row = blockIdx.x * 4 + (threadIdx.x >> 6);
    const float* xr = p.out + (size_t)row * DM; float s = 0.f;
    for (int i = lane; i < DM; i += 64) s += xr[i] * xr[i];
    for (int o = 1; o < 64; o <<= 1) s += __shfl_xor(s, o);
    float* q = (float*)(p.ws + WS_SSQX) + (size_t)row * 16;
    if (lane < 16) q[lane] = lane == 0 ? s : 0.f;
}
__device__ __forceinline__ float rstd_x16(const Params& p, int row) { const float* q = (const float*)(p.ws + WS_SSQX) + (size_t)row * 16; float s = 0.f;
#pragma unroll
    for (int i = 0; i < 16; ++i) s += q[i]; return 1.f / sqrtf(s * (1.f / DM) + EPS); }
__global__ void __launch_bounds__(256) final_norm(Params p) {
    const int lane = threadIdx.x & 63, row = blockIdx.x * 4 + (threadIdx.x >> 6);
    const float r = rstd_x16(p, row); float* xr = p.out + (size_t)row * DM;
    for (int i = lane; i < DM; i += 64) xr[i] = xr[i] * r * p.g_final[i];
}

struct E1 { Params p;
    __device__ void operator()(int row, int col, const float* a) const {
        const int b = row / SEQ; const float r = ((const float*)(p.ws + WS_RSTDX))[row]; const float* bd = (const float*)(p.ws + WS_BIASD) + b * ND;
        float v[4];
#pragma unroll
        for (int i = 0; i < 4; ++i) v[i] = r * a[i] + bd[col + i];
        if (col < 640) { bf16_t* o = (bf16_t*)(p.ws + WS_RAW) + (size_t)row * ND + col;
#pragma unroll
            for (int i = 0; i < 4; ++i) o[i] = (bf16_t)f2bf(v[i]); }
        else if (col < 704) { const int j = col - 640;
#pragma unroll
            for (int pr = 0; pr < 2; ++pr) { const int i = (j >> 1) + pr; const float* cs = (const float*)(p.ws + WS_ROPE) + ((size_t)row * 32 + i) * 2;
                const float x1 = v[2 * pr], x2 = v[2 * pr + 1], o1 = x1 * cs[0] - x2 * cs[1], o2 = x1 * cs[1] + x2 * cs[0];
                for (int h = 0; h < NHM; ++h) { bf16_t* o = (bf16_t*)(p.ws + WS_K) + (size_t)row * 1536 + h * 192 + 128 + j + 2 * pr; o[0] = (bf16_t)f2bf(o1); o[1] = (bf16_t)f2bf(o2); } } }
    }
};
struct E2q { Params p;
    __device__ void operator()(int row, int col, const float* a) const {
        const float* q = (const float*)(p.ws + WS_SSQ1) + (size_t)row * 24; float s = 0.f;
#pragma unroll
        for (int i = 0; i < 12; ++i) s += q[i];
        const float r = 1.f / sqrtf(s * (1.f / QL) + EPS); float v[4];
#pragma unroll
        for (int i = 0; i < 4; ++i) v[i] = r * a[i];
        const int cc = col % 192;
        if (cc >= 128) { const int j = cc - 128;
#pragma unroll
            for (int pr = 0; pr < 2; ++pr) { const int i = (j >> 1) + pr; const float* cs = (const float*)(p.ws + WS_ROPE) + ((size_t)row * 32 + i) * 2;
                const float x1 = v[2 * pr], x2 = v[2 * pr + 1]; v[2 * pr] = x1 * cs[0] - x2 * cs[1]; v[2 * pr + 1] = x1 * cs[1] + x2 * cs[0]; } }
        bf16_t* o = (bf16_t*)(p.ws + WS_Q) + (size_t)row * 1536 + col;
#pragma unroll
        for (int i = 0; i < 4; ++i) o[i] = (bf16_t)f2bf(v[i] * C2_MLA);
    }
};
struct E2kv { Params p;
    __device__ void operator()(int row, int col, const float* a) const {
        const float* q = (const float*)(p.ws + WS_SSQ1) + (size_t)row * 24; float s = 0.f;
#pragma unroll
        for (int i = 12; i < 20; ++i) s += q[i];
        const float r = 1.f / sqrtf(s * (1.f / KVL) + EPS);
        const int h = col / 256, cc = col % 256;
        bf16_t* o = cc < 128 ? (bf16_t*)(p.ws + WS_K) + (size_t)row * 1536 + h * 192 + cc : (bf16_t*)(p.ws + WS_V) + (size_t)row * 1024 + h * 128 + (cc - 128);
#pragma unroll
        for (int i = 0; i < 4; ++i) o[i] = (bf16_t)f2bf(r * a[i]);
    }
};
struct E4 { Params p; int l, pad;
    __device__ void operator()(int row, int col, const float* a) const {
        const int b = row / SEQ; const float* gt = modp(p, l, b, 2) + col; const float* sc = modp(p, l, b, 4) + col; const float* g = p.g_mlp + l * 1024 + col;
        const float* xin = (l == 0 ? p.x : p.out) + (size_t)row * DM + col; float* xo = p.out + (size_t)row * DM + col; bf16_t* xn = (bf16_t*)(p.ws + WS_XN) + (size_t)row * DM + col;
#pragma unroll
        for (int i = 0; i < 4; ++i) { const float y = a[i] + (l == 1 ? p.swa_b_o[col + i] : 0.f); const float x1 = xin[i] + gt[i] * y; xo[i] = x1; xn[i] = (bf16_t)f2bf(x1 * (g[i] * (1.f + sc[i]))); }
    }
};
struct E5 { Params p; int l, pad;
    __device__ void operator()(int row, int col, const float* a) const {
        const int b = row / SEQ; const float r = rstd_x16(p, row); const float* bu = (const float*)(p.ws + WS_BIASU) + (l * 2 + b) * FF + col;
        bf16_t* o = (bf16_t*)(p.ws + WS_H) + (size_t)row * FF + col;
#pragma unroll
        for (int i = 0; i < 4; ++i) { const float v = fmaxf(r * a[i] + bu[i], 0.f); o[i] = (bf16_t)f2bf(v * v); }
    }
};
struct E6 { Params p; int l, pad;
    __device__ void operator()(int row, int col, const float* a) const {
        const int b = row / SEQ; const float* gt = modp(p, l, b, 5) + col; float* xo = p.out + (size_t)row * DM + col;
        float x2[4];
#pragma unroll
        for (int i = 0; i < 4; ++i) { x2[i] = xo[i] + gt[i] * a[i]; xo[i] = x2[i]; }
        if (l == 0) { const float* sc = modp(p, 1, b, 1) + col; const float* g = p.g_mix + 1024 + col; bf16_t* xn = (bf16_t*)(p.ws + WS_XN) + (size_t)row * DM + col;
#pragma unroll
            for (int i = 0; i < 4; ++i) xn[i] = (bf16_t)f2bf(x2[i] * (g[i] * (1.f + sc[i]))); }
    }
};
struct E7 { Params p;
    __device__ void operator()(int row, int col, const float* a) const {
        const int b = row / SEQ; const float r = rstd_x16(p, row); const float* bq = (const float*)(p.ws + WS_BIASQ) + b * 1536 + col;
        bf16_t* o; float sc = 1.f;
        if (col < 1024) { o = (bf16_t*)(p.ws + WS_Q1) + (size_t)row * 1024 + col; sc = C2_SWA; }
        else if (col < 1280) o = (bf16_t*)(p.ws + WS_K1) + (size_t)row * 256 + (col - 1024);
        else o = (bf16_t*)(p.ws + WS_V1) + (size_t)row * 256 + (col - 1280);
#pragma unroll
        for (int i = 0; i < 4; ++i) o[i] = (bf16_t)f2bf((r * a[i] + bq[i]) * sc);
    }
};
template <class Epi>
__global__ void __launch_bounds__(256) gemm(const bf16_t* A, const bf16_t* Wt, int lda, int N, int K, int pad, Epi E) {
    __shared__ float As[16][68], Ws[16][68];
    const int tx = threadIdx.x & 15, ty = threadIdx.x >> 4, row0 = blockIdx.y * 64, col0 = blockIdx.x * 64;
    float acc[4][4];
#pragma unroll
    for (int i = 0; i < 4; ++i)
#pragma unroll
        for (int j = 0; j < 4; ++j) acc[i][j] = 0.f;
    for (int k0 = 0; k0 < K; k0 += 16) {
#pragma unroll
        for (int i = 0; i < 4; ++i) { const int e = threadIdx.x + 256 * i, r = e >> 4, kk = e & 15;
            As[kk][r] = bf2f(A[(size_t)(row0 + r) * lda + k0 + kk]); Ws[kk][r] = bf2f(Wt[(size_t)(col0 + r) * K + k0 + kk]); }
        __syncthreads();
#pragma unroll
        for (int kk = 0; kk < 16; ++kk) { float a[4], w[4];
#pragma unroll
            for (int i = 0; i < 4; ++i) { a[i] = As[kk][ty * 4 + i]; w[i] = Ws[kk][tx * 4 + i]; }
#pragma unroll
            for (int i = 0; i < 4; ++i)
#pragma unroll
                for (int j = 0; j < 4; ++j) acc[i][j] += a[i] * w[j]; }
        __syncthreads();
    }
#pragma unroll
    for (int i = 0; i < 4; ++i) { float v[4] = {acc[i][0], acc[i][1], acc[i][2], acc[i][3]}; E(row0 + ty * 4 + i, col0 + tx * 4, v); }
}
template <bool SWA>
__global__ void __launch_bounds__(256) attn(Params p) {
    constexpr int DQ = SWA ? 64 : 192, DV = SWA ? 64 : 128, NQ = DQ / 64, NV = DV / 64, H = SWA ? SHQ : NHM;
    constexpr int QP = SWA ? 1024 : 1536, KP = SWA ? 256 : 1536, VP = SWA ? 256 : 1024;
    const int lane = threadIdx.x & 63; const long gid = (long)blockIdx.x * 4 + (threadIdx.x >> 6);
    const int q = (int)(gid % SEQ), h = (int)((gid / SEQ) % H), b = (int)(gid / ((long)SEQ * H));
    const bf16_t* Qr = (const bf16_t*)(p.ws + (SWA ? WS_Q1 : WS_Q)) + (size_t)(b * SEQ + q) * QP + h * DQ;
    const bf16_t* Kb = (const bf16_t*)(p.ws + (SWA ? WS_K1 : WS_K)) + (size_t)b * SEQ * KP + (SWA ? (h / 4) * 64 : h * 192);
    const bf16_t* Vb = (const bf16_t*)(p.ws + (SWA ? WS_V1 : WS_V)) + (size_t)b * SEQ * VP + (SWA ? (h / 4) * 64 : h * 128);
    bf16_t* Or = (bf16_t*)(p.ws + WS_O) + (size_t)(b * SEQ + q) * 1024 + h * DV;
    float qv[NQ];
#pragma unroll
    for (int i = 0; i < NQ; ++i) qv[i] = bf2f(Qr[lane + 64 * i]);
    const int jlo = SWA ? (q - (SWIN - 1) > 0 ? q - (SWIN - 1) : 0) : 0;
    const float slope2 = SWA ? exp2f(-0.5f * (float)(h + 1)) * LOG2E : 0.f;
    float m = SWA ? p.swa_sinks[h] * LOG2E : -1e30f, l = SWA ? 1.f : 0.f; float o[NV];
#pragma unroll
    for (int i = 0; i < NV; ++i) o[i] = 0.f;
    for (int j0 = jlo; j0 <= q; j0 += 64) {
        const int j = j0 + lane; const bool valid = j <= q; const int jc = valid ? j : q;
        const uint4* kr = (const uint4*)(Kb + (size_t)jc * KP); float s = 0.f;
#pragma unroll
        for (int c8 = 0; c8 < DQ / 8; ++c8) { const uint4 kk = kr[c8]; const unsigned w[4] = {kk.x, kk.y, kk.z, kk.w};
#pragma unroll
            for (int e = 0; e < 8; ++e) { const int d = c8 * 8 + e; const float qd = __uint_as_float(__builtin_amdgcn_readlane(__float_as_uint(qv[d / 64]), d % 64));
                const float kd = (e & 1) ? __uint_as_float(w[e >> 1] & 0xffff0000u) : __uint_as_float(w[e >> 1] << 16); s += qd * kd; } }
        if (SWA) s -= slope2 * (float)(q - j);
        if (!valid) s = -__builtin_inff();
        float mx = s;
        for (int t = 1; t < 64; t <<= 1) mx = fmaxf(mx, __shfl_xor(mx, t));
        const float mn = fmaxf(m, mx), alpha = exp2f(m - mn), pj = exp2f(s - mn);
        float ps = pj;
        for (int t = 1; t < 64; t <<= 1) ps += __shfl_xor(ps, t);
        l = l * alpha + ps; m = mn;
#pragma unroll
        for (int i = 0; i < NV; ++i) o[i] *= alpha;
        for (int jj = 0; jj < 64; ++jj) { const float pb = __shfl(pj, jj); int r = j0 + jj; r = r <= q ? r : q; const bf16_t* vr = Vb + (size_t)r * VP;
#pragma unroll
            for (int i = 0; i < NV; ++i) o[i] += pb * bf2f(vr[lane + 64 * i]); }
    }
    const float il = 1.f / l;
#pragma unroll
    for (int i = 0; i < NV; ++i) Or[lane + 64 * i] = (bf16_t)f2bf(o[i] * il);
}
}
namespace pg8 {
#define PG8_LAS __attribute__((address_space(3)))
typedef short bf16x8 __attribute__((ext_vector_type(8)));
typedef float f32x4 __attribute__((ext_vector_type(4)));
typedef unsigned u32x4 __attribute__((ext_vector_type(4)));
constexpr int BM = 256, BK = 64, HALF = 128, HTB = HALF * BK * 2  , STAGE_BYTES = 8 * HTB, NXCD = 8, WGM = 8;

__host__ __device__ __forceinline__ int lds_byte(int r, int c) { const int st = (r >> 4) * 2 + (c >> 5), rr = r & 15, cc = c & 31, ob = rr * 64 + cc * 2; return st * 1024 + (ob ^ (((ob >> 9) & 1) << 5)); }
__host__ __device__ __forceinline__ void stage_rc(int b, int& R, int& C) { const int st = b / 1024, sb = b % 1024, swz = sb ^ (((sb >> 9) & 1) << 5); R = (st >> 1) * 16 + swz / 64; C = (st & 1) * 32 + (swz % 64) / 2; }
__host__ __device__ __forceinline__ int perm32(int rho) { const int n = rho >> 4, i = rho & 15; return 8 * (i >> 2) + 4 * n + (i & 3); }

struct Unit { int pm, pn; };
struct Gemm { const bf16_t* A; const bf16_t* Bt; int lda, N, K; };

struct StaticOrder {
    int nM, nN, nwg, G, c;
    __host__ __device__ void init(int M_, int N, int G_, int c_) { nM = M_ / BM; nN = N / BM; nwg = nM * nN; G = G_; c = c_; }
    __host__ __device__ bool next(int i, Unit& u) const {
        const long L = (long)i * G + c; if (L >= nwg) return false;
        int wgid = (int)L; { const int q = nwg / NXCD, r = nwg % NXCD, xcd = wgid % NXCD, off = wgid / NXCD; wgid = (xcd < r ? xcd * (q + 1) : r * (q + 1) + (xcd - r) * q) + off; }
        const int nig = WGM * nN, gid = wgid / nig, fm = gid * WGM, gsz = (nM - fm) < WGM ? (nM - fm) : WGM;
        u.pm = fm + ((wgid % nig) % gsz); u.pn = (wgid % nig) / gsz; return true;
    }
};

__device__ __forceinline__ unsigned cvt_pk_bf16(float lo, float hi) { unsigned r; asm volatile("v_cvt_pk_bf16_f32 %0, %1, %2" : "=v"(r) : "v"(lo), "v"(hi)); return r; }
__device__ __forceinline__ u32x4 pack8(const f32x4& a, const f32x4& b) { u32x4 w; w.x = cvt_pk_bf16(a[0], a[1]); w.y = cvt_pk_bf16(a[2], a[3]); w.z = cvt_pk_bf16(b[0], b[1]); w.w = cvt_pk_bf16(b[2], b[3]); return w; }

template <class Epi, bool ALIGN_EPI>
__device__ __forceinline__ void gemm_phase(PG8_LAS unsigned char* lds, const Gemm g, const StaticOrder& S, const Epi& E) {
    int tid_ = threadIdx.x; asm volatile("" : "+v"(tid_));
    const int tid = tid_, wid = __builtin_amdgcn_readfirstlane(tid >> 6), lane = tid & 63, wr = wid >> 2, wc = wid & 3, fr = lane & 15, fq = lane >> 4;
    const int K = g.K, nt = K / BK, lda = g.lda;
    unsigned voffA[2], voffB[2];
#pragma unroll
    for (int i = 0; i < 2; ++i) { int R, C; stage_rc(tid * 16 + i * 8192, R, C); const int Rb = (R & ~31) + perm32(R & 31);
        voffA[i] = (unsigned)(R * lda + C) * 2u; voffB[i] = (unsigned)(Rb * K + C) * 2u; }
    const size_t kstep = (size_t)(BK * 2);
    const size_t hstepA = (size_t)HALF * lda * 2, hstepB = (size_t)HALF * K * 2;
    const size_t tstepA = 2 * hstepA, tstepB = 2 * hstepB;
    const unsigned ldsw = (unsigned)wid * 1024u;
    const int aoff = lds_byte(wr * 64 + fr, fq * 8), boff = lds_byte(wc * 32 + fr, fq * 8);
#define PG8_SA(b, h) (((b) * 2 + (h)) * HTB)
#define PG8_SB(b, h) ((4 + (b) * 2 + (h)) * HTB)
#define PG8_STAGE(bufoff, gbase, voff) do { _Pragma("unroll") for (int _i = 0; _i < 2; ++_i) \
        __builtin_amdgcn_global_load_lds((const unsigned*)((const char*)(gbase) + (voff)[_i]), (PG8_LAS unsigned*)(lds + (bufoff) + ldsw + _i * 8192), 16, 0, 0); } while (0)
#define PG8_LDA(dst, b, h) do { _Pragma("unroll") for (int m = 0; m < 4; ++m) _Pragma("unroll") for (int k = 0; k < 2; ++k) dst[m][k] = *(const PG8_LAS bf16x8*)(lds + PG8_SA(b, h) + aoff + m * 2048 + k * 1024); } while (0)
#define PG8_LDB(dst, b, h) do { _Pragma("unroll") for (int n = 0; n < 2; ++n) _Pragma("unroll") for (int k = 0; k < 2; ++k) dst[n][k] = *(const PG8_LAS bf16x8*)(lds + PG8_SB(b, h) + boff + n * 2048 + k * 1024); } while (0)
#define PG8_MMA(ai, bj, At, Bt) do { __builtin_amdgcn_s_setprio(1); _Pragma("unroll") for (int m = 0; m < 4; ++m) _Pragma("unroll") for (int n = 0; n < 2; ++n) _Pragma("unroll") for (int k = 0; k < 2; ++k) \
        acc[ai][bj][m][n] = __builtin_amdgcn_mfma_f32_16x16x32_bf16(Bt[n][k], At[m][k], acc[ai][bj][m][n], 0, 0, 0); __builtin_amdgcn_s_setprio(0); } while (0)
#define PG8_WAIT_V(n) asm volatile("s_waitcnt vmcnt(" #n ")" ::: "memory")
#define PG8_WAIT_L(n) asm volatile("s_waitcnt lgkmcnt(" #n ")" ::: "memory")
#define PG8_BAR __builtin_amdgcn_s_barrier()
#define PG8_SCHED __builtin_amdgcn_sched_barrier(0)
    Unit cur, nxt; int ui = 0;
    if (!S.next(0, cur)) return;
    f32x4 acc[2][2][4][2];
#pragma unroll
    for (int a = 0; a < 2; ++a)
#pragma unroll
        for (int b = 0; b < 2; ++b)
#pragma unroll
            for (int m = 0; m < 4; ++m)
#pragma unroll
                for (int n = 0; n < 2; ++n) acc[a][b][m][n] = (f32x4){0.f, 0.f, 0.f, 0.f};
    bf16x8 At[4][2], B0[2][2], B1[2][2];
    const char* cA = (const char*)g.A + (size_t)cur.pm * tstepA; const char* cB = (const char*)g.Bt + (size_t)cur.pn * tstepB;
    PG8_STAGE(PG8_SB(0, 0), cB, voffB); PG8_STAGE(PG8_SB(0, 1), cB + hstepB, voffB); PG8_STAGE(PG8_SA(0, 0), cA, voffA); PG8_STAGE(PG8_SA(0, 1), cA + hstepA, voffA);
    if (wr == 1) PG8_BAR;
    PG8_WAIT_V(2); PG8_BAR;
    PG8_STAGE(PG8_SB(1, 0), cB + kstep, voffB); PG8_STAGE(PG8_SA(1, 0), cA + kstep, voffA); PG8_STAGE(PG8_SB(1, 1), cB + hstepB + kstep, voffB);
    PG8_WAIT_V(6); PG8_BAR;
    for (;;) {
        const bool has_next = S.next(ui + 1, nxt);
        const char* nA = has_next ? (const char*)g.A + (size_t)nxt.pm * tstepA : cA; const char* nB = has_next ? (const char*)g.Bt + (size_t)nxt.pn * tstepB : cB;
        for (int t = 0; t < nt; t += 2) {
            const bool last = (t == nt - 2);
            const char* a1 = cA + (size_t)(t + 1) * kstep;
            const char* a2 = last ? nA : cA + (size_t)(t + 2) * kstep; const char* b2 = last ? nB : cB + (size_t)(t + 2) * kstep;
            const char* a3 = a2 + kstep; const char* b3 = b2 + kstep;
            PG8_LDB(B0, 0, 0); PG8_LDB(B1, 0, 1); PG8_SCHED; PG8_LDA(At, 0, 0); PG8_STAGE(PG8_SA(1, 1), a1 + hstepA, voffA);
            PG8_WAIT_V(8); PG8_WAIT_L(0); PG8_BAR; PG8_MMA(0, 0, At, B0); PG8_MMA(0, 1, At, B1); PG8_BAR; PG8_SCHED;
            PG8_LDA(At, 0, 1); PG8_STAGE(PG8_SB(0, 0), b2, voffB); PG8_STAGE(PG8_SB(0, 1), b2 + hstepB, voffB); PG8_STAGE(PG8_SA(0, 0), a2, voffA);
            PG8_WAIT_V(8); PG8_WAIT_L(0); PG8_BAR; PG8_MMA(1, 0, At, B0); PG8_MMA(1, 1, At, B1); PG8_BAR; PG8_SCHED;
            PG8_LDB(B0, 1, 0); PG8_LDB(B1, 1, 1); PG8_SCHED; PG8_LDA(At, 1, 0); PG8_STAGE(PG8_SA(0, 1), a2 + hstepA, voffA);
            PG8_WAIT_V(8); PG8_WAIT_L(0); PG8_BAR; PG8_MMA(0, 0, At, B0); PG8_MMA(0, 1, At, B1); PG8_BAR; PG8_SCHED;
            PG8_LDA(At, 1, 1); PG8_STAGE(PG8_SB(1, 0), b3, voffB); PG8_STAGE(PG8_SB(1, 1), b3 + hstepB, voffB); PG8_STAGE(PG8_SA(1, 0), a3, voffA);
            PG8_WAIT_V(8); PG8_WAIT_L(0); PG8_BAR; PG8_MMA(1, 0, At, B0); PG8_MMA(1, 1, At, B1); PG8_BAR; PG8_SCHED;
        }
        if constexpr (ALIGN_EPI) { if (wr == 0) PG8_BAR; }
        { int l2; asm volatile("v_mbcnt_lo_u32_b32 %0, -1, 0\n\tv_mbcnt_hi_u32_b32 %0, -1, %0" : "=v"(l2)); E(acc, cur, wr, wc, l2 & 15, l2 >> 4); }
        if (!has_next) break;
#pragma unroll
        for (int a = 0; a < 2; ++a)
#pragma unroll
            for (int b = 0; b < 2; ++b)
#pragma unroll
                for (int m = 0; m < 4; ++m)
#pragma unroll
                    for (int n = 0; n < 2; ++n) acc[a][b][m][n] = (f32x4){0.f, 0.f, 0.f, 0.f};
        cur = nxt; cA = nA; cB = nB; ++ui;
        if constexpr (ALIGN_EPI) { if (wr == 1) PG8_BAR; }
    }
    PG8_WAIT_V(0);
    if constexpr (!ALIGN_EPI) { if (wr == 0) PG8_BAR; }
    PG8_BAR;
#undef PG8_SA
#undef PG8_SB
#undef PG8_STAGE
#undef PG8_LDA
#undef PG8_LDB
#undef PG8_MMA
#undef PG8_WAIT_V
#undef PG8_WAIT_L
#undef PG8_BAR
#undef PG8_SCHED
}

typedef const f32x4 (&AccRef)[2][2][4][2];
__device__ __forceinline__ float sum4sq(const f32x4& v) { return (v[0] * v[0] + v[1] * v[1]) + (v[2] * v[2] + v[3] * v[3]); }
__device__ __forceinline__ float rstd16(const float* q, float invn) { const f32x4 a = *(const f32x4*)q, b = *(const f32x4*)(q + 4), c = *(const f32x4*)(q + 8), d = *(const f32x4*)(q + 12);
    const float s = ((a[0] + a[1]) + (a[2] + a[3])) + ((b[0] + b[1]) + (b[2] + b[3])) + ((c[0] + c[1]) + (c[2] + c[3])) + ((d[0] + d[1]) + (d[2] + d[3])); return __builtin_amdgcn_rsqf(s * invn + EPS); }
__device__ __forceinline__ void rope8(f32x4& v0, f32x4& v1, const float* cs) {
    const f32x4 c0 = *(const f32x4*)cs, c1 = *(const f32x4*)(cs + 4);
    f32x4 o0, o1;
    o0[0] = v0[0] * c0[0] - v0[1] * c0[1]; o0[1] = v0[0] * c0[1] + v0[1] * c0[0]; o0[2] = v0[2] * c0[2] - v0[3] * c0[3]; o0[3] = v0[2] * c0[3] + v0[3] * c0[2];
    o1[0] = v1[0] * c1[0] - v1[1] * c1[1]; o1[1] = v1[0] * c1[1] + v1[1] * c1[0]; o1[2] = v1[2] * c1[2] - v1[3] * c1[3]; o1[3] = v1[2] * c1[3] + v1[3] * c1[2];
    v0 = o0; v1 = o1;
}
struct EpiDown { unsigned char* ws;
    __device__ __forceinline__ void operator()(AccRef acc, const Unit& u, int wr, int wc, int fr, int fq) const {
        const int row0 = u.pm * BM + wr * 64 + fr, b = u.pm >> 5, cb = u.pn * BM + wc * 32 + 8 * fq;
        const float* bd = (const float*)(ws + WS_BIASD) + b * ND + cb; f32x4 bv[2][2];
#pragma unroll
        for (int bj = 0; bj < 2; ++bj)
#pragma unroll
            for (int n = 0; n < 2; ++n) bv[bj][n] = *(const f32x4*)(bd + bj * HALF + 4 * n);
#pragma unroll
        for (int ai = 0; ai < 2; ++ai)
#pragma unroll
            for (int m = 0; m < 4; ++m) { int row = row0 + ai * HALF + m * 16; asm volatile("" : "+v"(row)); const float r = ((const float*)(ws + WS_RSTDX))[row];
#pragma unroll
                for (int bj = 0; bj < 2; ++bj) { const int c8 = cb + bj * HALF; f32x4 v0 = acc[ai][bj][m][0] * r + bv[bj][0], v1 = acc[ai][bj][m][1] * r + bv[bj][1];
                    if (c8 < 640) { *(u32x4*)((bf16_t*)(ws + WS_RAW) + (size_t)row * ND + c8) = pack8(v0, v1);
                        float ss = sum4sq(v0) + sum4sq(v1); ss += __shfl_xor(ss, 16); ss += __shfl_xor(ss, 32);
                        if (fq == 0) ((float*)(ws + WS_SSQ1))[(size_t)row * 24 + u.pn * 8 + bj * 4 + wc] = ss; }
                    else if (c8 < 704) { const int j = c8 - 640; rope8(v0, v1, (const float*)(ws + WS_ROPE) + ((size_t)row * 32 + (j >> 1)) * 2); const u32x4 w = pack8(v0, v1);
                        bf16_t* kp = (bf16_t*)(ws + WS_K) + (size_t)row * 1536 + 128 + j;
#pragma unroll
                        for (int h = 0; h < NHM; ++h) *(u32x4*)(kp + h * 192) = w; } }
                asm volatile("" ::: "memory"); }
    }
};
struct EpiQ { unsigned char* ws;
    __device__ __forceinline__ void operator()(AccRef acc, const Unit& u, int wr, int wc, int fr, int fq) const {
        const int row0 = u.pm * BM + wr * 64 + fr, cb = u.pn * BM + wc * 32 + 8 * fq;
#pragma unroll
        for (int ai = 0; ai < 2; ++ai)
#pragma unroll
            for (int m = 0; m < 4; ++m) { int row = row0 + ai * HALF + m * 16; asm volatile("" : "+v"(row)); const float* q = (const float*)(ws + WS_SSQ1) + (size_t)row * 24;
                const f32x4 a = *(const f32x4*)q, bb = *(const f32x4*)(q + 4), c = *(const f32x4*)(q + 8);
                const float r = __builtin_amdgcn_rsqf((((a[0] + a[1]) + (a[2] + a[3])) + ((bb[0] + bb[1]) + (bb[2] + bb[3])) + ((c[0] + c[1]) + (c[2] + c[3]))) * (1.f / QL) + EPS);
#pragma unroll
                for (int bj = 0; bj < 2; ++bj) { const int c8 = cb + bj * HALF; f32x4 v0 = acc[ai][bj][m][0] * r, v1 = acc[ai][bj][m][1] * r;
                    if ((4 * u.pn + 2 * bj + (wc >> 1)) % 3 == 2) rope8(v0, v1, (const float*)(ws + WS_ROPE) + ((size_t)row * 32 + (((wc & 1) * 32 + 8 * fq) >> 1)) * 2);
                    v0 = v0 * C2_MLA; v1 = v1 * C2_MLA;
                    *(u32x4*)((bf16_t*)(ws + WS_Q) + (size_t)row * 1536 + c8) = pack8(v0, v1); }
                asm volatile("" ::: "memory"); }
    }
};
struct EpiKV { unsigned char* ws;
    __device__ __forceinline__ void operator()(AccRef acc, const Unit& u, int wr, int wc, int fr, int fq) const {
        const int row0 = u.pm * BM + wr * 64 + fr, cw = wc * 32 + 8 * fq;
#pragma unroll
        for (int ai = 0; ai < 2; ++ai)
#pragma unroll
            for (int m = 0; m < 4; ++m) { int row = row0 + ai * HALF + m * 16; asm volatile("" : "+v"(row)); const float* q = (const float*)(ws + WS_SSQ1) + (size_t)row * 24 + 12;
                const f32x4 a = *(const f32x4*)q, bb = *(const f32x4*)(q + 4);
                const float r = __builtin_amdgcn_rsqf((((a[0] + a[1]) + (a[2] + a[3])) + ((bb[0] + bb[1]) + (bb[2] + bb[3]))) * (1.f / KVL) + EPS);
                *(u32x4*)((bf16_t*)(ws + WS_K) + (size_t)row * 1536 + u.pn * 192 + cw) = pack8(acc[ai][0][m][0] * r, acc[ai][0][m][1] * r);
                *(u32x4*)((bf16_t*)(ws + WS_V) + (size_t)row * 1024 + u.pn * 128 + cw) = pack8(acc[ai][1][m][0] * r, acc[ai][1][m][1] * r);
                asm volatile("" ::: "memory"); }
    }
};
struct EpiRes { const float* xin; float* xout; const float* gate; const float* bo; const float* g; const float* sc; unsigned char* ws;
    __device__ __forceinline__ void operator()(AccRef acc, const Unit& u, int wr, int wc, int fr, int fq) const {
        const int row0 = u.pm * BM + wr * 64 + fr, b = u.pm >> 5, cb = u.pn * BM + wc * 32 + 8 * fq;
        const float* gtp = gate + b * 6144 + cb; const float* scp = sc ? sc + b * 6144 + cb : nullptr;
#pragma unroll
        for (int ai = 0; ai < 2; ++ai)
#pragma unroll
            for (int m = 0; m < 4; ++m) { int row = row0 + ai * HALF + m * 16; asm volatile("" : "+v"(row)); float ss = 0.f;
#pragma unroll
                for (int bj = 0; bj < 2; ++bj) { const int cj = bj * HALF; const size_t off = (size_t)row * DM + cb + cj;
                    f32x4 y0 = acc[ai][bj][m][0], y1 = acc[ai][bj][m][1];
                    if (bo) { y0 = y0 + *(const f32x4*)(bo + cb + cj); y1 = y1 + *(const f32x4*)(bo + cb + cj + 4); }
                    const f32x4 x0 = *(const f32x4*)(xin + off) + *(const f32x4*)(gtp + cj) * y0, x1 = *(const f32x4*)(xin + off + 4) + *(const f32x4*)(gtp + cj + 4) * y1;
                    *(f32x4*)(xout + off) = x0; *(f32x4*)(xout + off + 4) = x1; ss += sum4sq(x0) + sum4sq(x1);
                    if (g) { const f32x4 g0 = *(const f32x4*)(g + cb + cj) * (*(const f32x4*)(scp + cj) + 1.f), g1 = *(const f32x4*)(g + cb + cj + 4) * (*(const f32x4*)(scp + cj + 4) + 1.f);
                        *(u32x4*)((bf16_t*)(ws + WS_XN) + off) = pack8(x0 * g0, x1 * g1); } }
                ss += __shfl_xor(ss, 16); ss += __shfl_xor(ss, 32);
                if (fq == 0) ((float*)(ws + WS_SSQX))[(size_t)row * 16 + u.pn * 4 + wc] = ss;
                asm volatile("" ::: "memory"); }
    }
};
struct EpiUp { const float* biasu; unsigned char* ws;
    __device__ __forceinline__ void operator()(AccRef acc, const Unit& u, int wr, int wc, int fr, int fq) const {
        const int row0 = u.pm * BM + wr * 64 + fr, b = u.pm >> 5, cb = u.pn * BM + wc * 32 + 8 * fq; f32x4 bv[2][2];
#pragma unroll
        for (int bj = 0; bj < 2; ++bj)
#pragma unroll
            for (int n = 0; n < 2; ++n) bv[bj][n] = *(const f32x4*)(biasu + b * FF + cb + bj * HALF + 4 * n);
#pragma unroll
        for (int ai = 0; ai < 2; ++ai)
#pragma unroll
            for (int m = 0; m < 4; ++m) { int row = row0 + ai * HALF + m * 16; asm volatile("" : "+v"(row)); const float r = rstd16((const float*)(ws + WS_SSQX) + (size_t)row * 16, 1.f / DM);
#pragma unroll
                for (int bj = 0; bj < 2; ++bj) { f32x4 v0 = acc[ai][bj][m][0] * r + bv[bj][0], v1 = acc[ai][bj][m][1] * r + bv[bj][1];
#pragma unroll
                    for (int i = 0; i < 4; ++i) { v0[i] = fmaxf(v0[i], 0.f); v1[i] = fmaxf(v1[i], 0.f); }
                    *(u32x4*)((bf16_t*)(ws + WS_H) + (size_t)row * FF + cb + bj * HALF) = pack8(v0 * v0, v1 * v1); }
                if (m & 1) asm volatile("" ::: "memory"); }
    }
};
struct EpiQKV1 { unsigned char* ws;
    __device__ __forceinline__ void operator()(AccRef acc, const Unit& u, int wr, int wc, int fr, int fq) const {
        const int row0 = u.pm * BM + wr * 64 + fr, b = u.pm >> 5, cw = wc * 32 + 8 * fq, cb = u.pn * BM + cw; f32x4 bv[2][2];
#pragma unroll
        for (int bj = 0; bj < 2; ++bj)
#pragma unroll
            for (int n = 0; n < 2; ++n) bv[bj][n] = *(const f32x4*)((const float*)(ws + WS_BIASQ) + b * 1536 + cb + bj * HALF + 4 * n);
        bf16_t* base; int ld; float sc = 1.f;
        if (u.pn < 4) { base = (bf16_t*)(ws + WS_Q1) + cb; ld = 1024; sc = C2_SWA; } else if (u.pn == 4) { base = (bf16_t*)(ws + WS_K1) + cw; ld = 256; } else { base = (bf16_t*)(ws + WS_V1) + cw; ld = 256; }
#pragma unroll
        for (int ai = 0; ai < 2; ++ai)
#pragma unroll
            for (int m = 0; m < 4; ++m) { int row = row0 + ai * HALF + m * 16; asm volatile("" : "+v"(row)); const float r = rstd16((const float*)(ws + WS_SSQX) + (size_t)row * 16, 1.f / DM);
#pragma unroll
                for (int bj = 0; bj < 2; ++bj) *(u32x4*)(base + (size_t)row * ld + bj * HALF) = pack8((acc[ai][bj][m][0] * r + bv[bj][0]) * sc, (acc[ai][bj][m][1] * r + bv[bj][1]) * sc);
                if (m & 1) asm volatile("" ::: "memory"); }
    }
};
}
constexpr int NWAVES = 8;
constexpr int N_PHASES = 14;
constexpr int CW_TMO = 0, CW_CODE = 1;
constexpr int CW_BAR = 4096;
constexpr int RING_OFF = 0, RING_BYTES = 131072;
constexpr int LDSCTL_OFF = RING_BYTES, MISC_OFF = LDSCTL_OFF + 320;
constexpr int LDS_BYTES = 147456;
#define GAS __attribute__((address_space(1)))
#define LAS __attribute__((address_space(3)))
typedef unsigned v4u __attribute__((ext_vector_type(4)));
typedef float f32x4 __attribute__((ext_vector_type(4)));
typedef GAS unsigned gu32;
#define RLX_AGENT __ATOMIC_RELAXED, __HIP_MEMORY_SCOPE_AGENT
#define LDS_WAIT() asm volatile("s_waitcnt lgkmcnt(0)" ::: "memory")
#define VM_WAIT() asm volatile("s_waitcnt vmcnt(0)" ::: "memory")

#define XB_TMO      128
#define XB_XCNT(j)  (256  + 64 * (j))
#define XB_XSUB(j)  (1280 + 64 * (j))
#define XB_XGEN(j)  (2304 + 64 * (j))
#define XB_TOP      3328
#define XB_TOPGEN   3392
#define XCD_BAR_WORDS 3456
#define XB_SPIN_CAP (1u << 18)
__device__ __forceinline__ unsigned xb_ld(unsigned* p)              { return __hip_atomic_load(p, __ATOMIC_RELAXED, __HIP_MEMORY_SCOPE_AGENT); }
__device__ __forceinline__ unsigned xb_add(unsigned* p, unsigned v) { return __hip_atomic_fetch_add(p, v, __ATOMIC_RELAXED, __HIP_MEMORY_SCOPE_AGENT); }
__device__ __forceinline__ unsigned xb_xcc_id() { return (unsigned)__builtin_amdgcn_s_getreg((3 << 11) | 20) & 0xFu; }
#define XB_SPIN(cond, bar) do { unsigned _sp = 0; while (cond) { __builtin_amdgcn_s_sleep(1); \
    if ((++_sp & 255u) == 0u) { if (xb_ld(&(bar)[XB_TMO])) break; if (_sp > XB_SPIN_CAP) { atomicAdd(&(bar)[XB_TMO], 1u); break; } } } } while (0)
struct XcdBarrier { unsigned* bar; unsigned x; volatile LAS unsigned* st; };
__device__ __forceinline__ XcdBarrier xcd_barrier_post(unsigned* bar, volatile LAS unsigned* st) {
    XcdBarrier b; b.bar = bar; b.x = xb_xcc_id(); b.st = st;
    if (threadIdx.x == 0) (void)xb_add(&bar[XB_XCNT(b.x)], 1u);
    return b;
}
__device__ __forceinline__ void xcd_barrier_complete(unsigned* bar, unsigned x, unsigned& nloc, unsigned& nx) {
    const unsigned G = gridDim.x * gridDim.y * gridDim.z;
    unsigned sum, cnt, mine, sp = 0u;
    for (;;) {
        sum = 0u; cnt = 0u; mine = 0u;
#pragma unroll
        for (unsigned j = 0; j < 16; ++j) { const unsigned c = xb_ld(&bar[XB_XCNT(j)]); sum += c; cnt += (c > 0u) ? 1u : 0u; mine = (j == x) ? c : mine; }
        if (sum == G) break;
        __builtin_amdgcn_s_sleep(1);
        if ((++sp & 255u) == 0u) { if (xb_ld(&bar[XB_TMO])) break; if (sp > XB_SPIN_CAP) { atomicAdd(&bar[XB_TMO], 1u); break; } }
    }
    nloc = mine > 0u ? mine : 1u; nx = cnt > 0u ? cnt : 1u;
}
__device__ __forceinline__ void xcd_barrier(const XcdBarrier& b) {
    asm volatile("s_waitcnt vmcnt(0)" ::: "memory");
    __syncthreads();
    if (threadIdx.x == 0) {
        unsigned* bar = b.bar;
        __builtin_amdgcn_s_waitcnt(0);
        unsigned nloc = b.st[0], nx = b.st[1];
        if (nloc == 0u) { xcd_barrier_complete(bar, b.x, nloc, nx); b.st[0] = nloc; b.st[1] = nx; }
        const unsigned old = xb_add(&bar[XB_XSUB(b.x)], 1u);
        const unsigned gen = old / nloc;
        if (old + 1u == (gen + 1u) * nloc) {
            __builtin_amdgcn_fence(__ATOMIC_RELEASE, "agent");
            asm volatile("s_waitcnt vmcnt(0)" ::: "memory");
            const unsigned og = xb_add(&bar[XB_TOP], 1u);
            const unsigned tg = og / nx;
            if (og + 1u == (tg + 1u) * nx) xb_add(&bar[XB_TOPGEN], 1u);
            else XB_SPIN(xb_ld(&bar[XB_TOPGEN]) == tg, bar);
            __builtin_amdgcn_fence(__ATOMIC_ACQUIRE, "agent");
            xb_add(&bar[XB_XGEN(b.x)], 1u);
            asm volatile("s_waitcnt vmcnt(0)" ::: "memory");
        } else {
            XB_SPIN(xb_ld(&bar[XB_XGEN(b.x)]) == gen, bar);
            __builtin_amdgcn_fence(__ATOMIC_ACQUIRE, "agent");
            asm volatile("s_waitcnt vmcnt(0)" ::: "memory");
        }
    }
    __syncthreads();
}

__device__ __forceinline__ float wave_sum(float v) {
#pragma unroll
    for (int o = 1; o < 64; o <<= 1) v += __shfl_xor(v, o);
    return v;
}
struct Frame { LAS unsigned char* lds; int tid, lane, wave, vcu, G; };

__device__ __forceinline__ void p0_transpose_item(const Params& p, int id, LAS float* scr, int item, int lane) {
    const int N = w_N(id), K = w_K(id); bf16_t* WT = (bf16_t*)(p.ws + w_off(id));
    const int nblk = N / 32, kb = item / nblk, nb = item % nblk, k0 = 64 * kb, n0 = 32 * nb;
    const float* src = nullptr; int ld = 0; const float* ksc = nullptr;
    switch (id) {
    case 0: if (n0 < 384) { src = p.w_dq + n0; ld = 384; } else if (n0 < 640) { src = p.w_dkv + (n0 - 384); ld = 320; } break;
    case 1: if (n0 % 192 < 128) { src = p.w_uq + n0; ld = 1536; ksc = p.g_q; } break;
    case 2: src = p.w_ukv + n0; ld = 2048; ksc = p.g_kv; break;
    case 3: src = p.mla_w_o + n0; ld = 1024; break;
    case 4: src = p.w_ff1 + n0; ld = FF; break;
    case 5: src = p.w_ff2 + n0; ld = 1024; break;
    case 6: src = p.swa_w_qkv + n0; ld = 1536; break;
    case 7: src = p.swa_w_o + n0; ld = 1024; break;
    case 8: src = p.w_ff1 + (size_t)1024 * FF + n0; ld = FF; break;
    default: src = p.w_ff2 + (size_t)FF * 1024 + n0; ld = 1024; break;
    }
    if (src) { const int kk8 = lane >> 3, n4 = (lane & 7) * 4; f32x4 v[8];
#pragma unroll
        for (int i = 0; i < 8; ++i) v[i] = *(const f32x4*)(src + (size_t)(k0 + kk8 + 8 * i) * ld + n4);
#pragma unroll
        for (int i = 0; i < 8; ++i) { const int kk = kk8 + 8 * i; const float sc = ksc ? ksc[k0 + kk] : 1.f; LAS float* d = scr + kk * 33 + n4;
            d[0] = v[i].x * sc; d[1] = v[i].y * sc; d[2] = v[i].z * sc; d[3] = v[i].w * sc; } }
    else {
#pragma unroll 4
        for (int i = 0; i < 32; ++i) { const int kk = 2 * i + (lane >> 5); scr[kk * 33 + (lane & 31)] = wsrc(p, id, k0 + kk, n0 + (lane & 31)); } }
    LDS_WAIT(); asm volatile("" ::: "memory");
    const int c = lane & 7;
#pragma unroll
    for (int j = 0; j < 4; ++j) { const int n = (lane >> 3) + 8 * j; const LAS float* s = scr + (8 * c) * 33 + n;
        v4u o; o.x = pk2(s[0 * 33], s[1 * 33]); o.y = pk2(s[2 * 33], s[3 * 33]); o.z = pk2(s[4 * 33], s[5 * 33]); o.w = pk2(s[6 * 33], s[7 * 33]);
        *(GAS v4u*)(WT + (size_t)(n0 + n) * K + k0 + 8 * c) = o; }
    LDS_WAIT(); asm volatile("" ::: "memory");
}
__device__ __forceinline__ void p0a(Frame& F, const Params& p) {
    if (F.vcu < 192) {
        const int l = F.vcu / 96, n0 = (F.vcu % 96) * 64, kq = F.lane >> 4, c4 = (F.lane & 15) * 4; const float* wa = p.w_ada + (size_t)l * 1024 * 6144 + n0 + c4;
        f32x4 a0 = {0.f, 0.f, 0.f, 0.f}, a1 = {0.f, 0.f, 0.f, 0.f}; const int kb = F.wave * 128 + kq;
#pragma unroll 8
        for (int i = 0; i < 32; ++i) { const int k = kb + 4 * i; const f32x4 w = *(const f32x4*)(wa + (size_t)k * 6144);
            const float c0 = p.c[k], c1 = p.c[1024 + k]; a0 = a0 + w * (c0 / (1.f + __expf(-c0))); a1 = a1 + w * (c1 / (1.f + __expf(-c1))); }
#pragma unroll
        for (int j = 0; j < 4; ++j) { a0[j] += __shfl_xor(a0[j], 16); a0[j] += __shfl_xor(a0[j], 32); a1[j] += __shfl_xor(a1[j], 16); a1[j] += __shfl_xor(a1[j], 32); }
        LAS float* red = (LAS float*)(F.lds + RING_OFF);
        if (kq == 0) { *(LAS f32x4*)(red + (F.wave * 2 + 0) * 64 + c4) = a0; *(LAS f32x4*)(red + (F.wave * 2 + 1) * 64 + c4) = a1; }
        __syncthreads();
        if (F.tid < 128) { const int b = F.tid >> 6, col = F.tid & 63; float s = 0.f;
#pragma unroll
            for (int w = 0; w < 8; ++w) s += red[(w * 2 + b) * 64 + col];
            ((float*)(p.ws + WS_MOD))[(l * 2 + b) * 6144 + n0 + col] = s + p.b_ada[l * 6144 + n0 + col]; }
        __syncthreads(); }
    { const int i = F.tid & 31; const float inv = powf(10000.f, -(float)i / 32.f);
      for (int e = F.vcu * 512 + F.tid; e < M * 32; e += F.G * 512) { const float ang = (float)p.pos[e >> 5] * inv; float sn, cs; sincosf(ang, &sn, &cs);
          float2* r = (float2*)(p.ws + WS_ROPE) + (size_t)e; *r = make_float2(cs, sn); } }
    LAS float* scr = (LAS float*)(F.lds + RING_OFF + 8192 + F.wave * 12288);
    const int gw = F.vcu * NWAVES + F.wave, NGW = F.G * NWAVES;
    constexpr int NI_TOTAL = 384 + 288 + 256 + 512 + 2048 + 2048 + 768 + 512 + 2048 + 2048;
    for (int it = gw; it < NI_TOTAL; it += NGW) { int r = it, id = 0;
#pragma unroll 1
        for (; id < 9; ++id) { const int ni = (w_K(id) / 64) * (w_N(id) / 32); if (r < ni) break; r -= ni; }
        p0_transpose_item(p, id, scr, r, F.lane); }
}
__device__ __forceinline__ float dot8(const v4u& w, const f32x4& s0, const f32x4& s1) {
    return (__uint_as_float(w.x << 16) * s0.x + __uint_as_float(w.x & 0xffff0000u) * s0.y) + (__uint_as_float(w.y << 16) * s0.z + __uint_as_float(w.y & 0xffff0000u) * s0.w)
         + (__uint_as_float(w.z << 16) * s1.x + __uint_as_float(w.z & 0xffff0000u) * s1.y) + (__uint_as_float(w.w << 16) * s1.z + __uint_as_float(w.w & 0xffff0000u) * s1.w);
}
__device__ __forceinline__ void p0b(Frame& F, const Params& p) {
    const int gw = F.vcu * NWAVES + F.wave, NGW = F.G * NWAVES;
    for (int o = gw; o < ND + 2 * FF + 1536; o += NGW) { int n = o, wid, l, hp; float* dst; int dstride; const float* addb = nullptr;
        if (n < ND) { wid = 0; l = 0; hp = 0; dst = (float*)(p.ws + WS_BIASD); dstride = ND; }
        else if (n < ND + FF) { n -= ND; wid = 4; l = 0; hp = 3; dst = (float*)(p.ws + WS_BIASU); dstride = FF; }
        else if (n < ND + 2 * FF) { n -= ND + FF; wid = 8; l = 1; hp = 3; dst = (float*)(p.ws + WS_BIASU) + 2 * FF; dstride = FF; }
        else { n -= ND + 2 * FF; wid = 6; l = 1; hp = 0; dst = (float*)(p.ws + WS_BIASQ); dstride = 1536; addb = p.swa_b_qkv; }
        const v4u* wr = (const v4u*)((const bf16_t*)(p.ws + w_off(wid)) + (size_t)n * 1024) + F.lane; const float* sh = modp(p, l, 0, hp) + F.lane * 8;
        const v4u w0 = wr[0], w1 = wr[64];
        float s0 = dot8(w0, *(const f32x4*)sh, *(const f32x4*)(sh + 4)) + dot8(w1, *(const f32x4*)(sh + 512), *(const f32x4*)(sh + 516));
        float s1 = dot8(w0, *(const f32x4*)(sh + 6144), *(const f32x4*)(sh + 6148)) + dot8(w1, *(const f32x4*)(sh + 6144 + 512), *(const f32x4*)(sh + 6144 + 516));
        s0 = wave_sum(s0); s1 = wave_sum(s1);
        if (F.lane == 0) { const float ab = addb ? addb[n] : 0.f; dst[n] = s0 + ab; dst[dstride + n] = s1 + ab; } }
    for (int m0 = gw * 4; m0 < M; m0 += NGW * 4) { const int b = m0 / SEQ; const f32x4* gm = (const f32x4*)p.g_mix + F.lane; const f32x4* sc = (const f32x4*)modp(p, 0, b, 1) + F.lane;
        f32x4 v[4][4]; float s[4];
#pragma unroll
        for (int r = 0; r < 4; ++r) { const GAS f32x4* xr = (const GAS f32x4*)(p.x + (size_t)(m0 + r) * DM) + F.lane;
#pragma unroll
            for (int j = 0; j < 4; ++j) v[r][j] = xr[64 * j]; }
#pragma unroll
        for (int r = 0; r < 4; ++r) { s[r] = 0.f;
#pragma unroll
            for (int j = 0; j < 4; ++j) s[r] += (v[r][j].x * v[r][j].x + v[r][j].y * v[r][j].y) + (v[r][j].z * v[r][j].z + v[r][j].w * v[r][j].w); }
#pragma unroll
        for (int o = 1; o < 64; o <<= 1) {
#pragma unroll
            for (int r = 0; r < 4; ++r) s[r] += __shfl_xor(s[r], o); }
        if (F.lane < 4) ((float*)(p.ws + WS_RSTDX))[m0 + F.lane] = __builtin_amdgcn_rsqf((F.lane == 0 ? s[0] : F.lane == 1 ? s[1] : F.lane == 2 ? s[2] : s[3]) * (1.f / DM) + EPS);
        f32x4 gs[4];
#pragma unroll
        for (int j = 0; j < 4; ++j) gs[j] = gm[64 * j] * (sc[64 * j] + 1.f);
#pragma unroll
        for (int r = 0; r < 4; ++r) { GAS unsigned long long* o8 = (GAS unsigned long long*)((bf16_t*)(p.ws + WS_XN) + (size_t)(m0 + r) * DM) + F.lane;
#pragma unroll
            for (int j = 0; j < 4; ++j) { const f32x4 o = v[r][j] * gs[j]; o8[64 * j] = (unsigned long long)pk2(o.x, o.y) | ((unsigned long long)pk2(o.z, o.w) << 32); } } }
}
__device__ __forceinline__ void p_final(Frame& F, const Params& p) {
    const int gw = F.vcu * NWAVES + F.wave, NGW = F.G * NWAVES; const f32x4* gf = (const f32x4*)p.g_final + F.lane;
    f32x4 g4[4];
#pragma unroll
    for (int j = 0; j < 4; ++j) g4[j] = gf[64 * j];
    for (int m0 = gw * 4; m0 < M; m0 += NGW * 4) { f32x4 v[4][4]; float r[4];
#pragma unroll
        for (int q = 0; q < 4; ++q) { const GAS f32x4* xr = (const GAS f32x4*)(p.out + (size_t)(m0 + q) * DM) + F.lane; r[q] = pg8::rstd16((const float*)(p.ws + WS_SSQX) + (size_t)(m0 + q) * 16, 1.f / DM);
#pragma unroll
            for (int j = 0; j < 4; ++j) v[q][j] = xr[64 * j]; }
#pragma unroll
        for (int q = 0; q < 4; ++q) { GAS f32x4* xo = (GAS f32x4*)(p.out + (size_t)(m0 + q) * DM) + F.lane;
#pragma unroll
            for (int j = 0; j < 4; ++j) xo[64 * j] = v[q][j] * r[q] * g4[j]; } }
}
namespace att {
typedef short bf16x8 __attribute__((ext_vector_type(8)));
typedef short s16x4 __attribute__((ext_vector_type(4)));
typedef float f32x16 __attribute__((ext_vector_type(16)));
typedef unsigned u32x4 __attribute__((ext_vector_type(4)));
#define ATT_SBAR() __builtin_amdgcn_sched_barrier(0)
__device__ __forceinline__ int crow(int r, int hi) { return (r & 3) + 8 * (r >> 2) + 4 * hi; }
__device__ __forceinline__ unsigned cvtpk(float lo, float hi) { unsigned r; asm volatile("v_cvt_pk_bf16_f32 %0, %1, %2" : "=v"(r) : "v"(lo), "v"(hi)); return r; }
template <int NC> __device__ __forceinline__ int v_st(int k, int c) { const int kk = (k & ~0xC) | ((k & 4) << 1) | ((k & 8) >> 1); return ((kk >> 3) * (NC / 32) + (c >> 5)) * 512 + ((kk & 7) * 32 + (c & 31)) * 2; }
__device__ __forceinline__ int v_rd_base(int lane) { return ((lane & 3) << 3) | (((lane >> 2) & 3) << 6) | (((lane >> 4) & 1) << 5) | (((lane >> 5) & 1) << 8); }
__device__ __forceinline__ float rowmax32(const f32x16& p0, const f32x16& p1) {
    float m = p0[0];
#pragma unroll
    for (int r = 1; r < 16; ++r) m = fmaxf(m, p0[r]);
#pragma unroll
    for (int r = 0; r < 16; ++r) m = fmaxf(m, p1[r]);
    auto rr = __builtin_amdgcn_permlane32_swap(__float_as_uint(m), __float_as_uint(m), false, false);
    return fmaxf(__uint_as_float(rr[0]), __uint_as_float(rr[1]));
}
__device__ __forceinline__ float softmax_tile(f32x16& p0, f32x16& p1, float& m_reg, float& l_reg, bf16x8& pa0, bf16x8& pa1, bf16x8& pa2, bf16x8& pa3) {
    const float pmax = rowmax32(p0, p1);
    const float mn = fmaxf(m_reg, pmax); const float alpha = __builtin_amdgcn_exp2f(m_reg - mn); m_reg = mn;
#pragma unroll
    for (int r = 0; r < 16; ++r) { p0[r] = __builtin_amdgcn_exp2f(p0[r] - mn); p1[r] = __builtin_amdgcn_exp2f(p1[r] - mn); }
    float ps = 0.f;
#pragma unroll
    for (int r = 0; r < 16; ++r) ps += p0[r];
#pragma unroll
    for (int r = 0; r < 16; ++r) ps += p1[r];
    { auto rr = __builtin_amdgcn_permlane32_swap(__float_as_uint(ps), __float_as_uint(ps), false, false); ps = __uint_as_float(rr[0]) + __uint_as_float(rr[1]); }
    l_reg = l_reg * alpha + ps;
#define ATT_PK4(P, B_, OUT) do { unsigned a0 = cvtpk(P[B_+0], P[B_+1]), a1 = cvtpk(P[B_+2], P[B_+3]); unsigned b0 = cvtpk(P[B_+4], P[B_+5]), b1 = cvtpk(P[B_+6], P[B_+7]); \
        auto r0 = __builtin_amdgcn_permlane32_swap(a0, b0, false, false); auto r1 = __builtin_amdgcn_permlane32_swap(a1, b1, false, false); \
        u32x4 w = {r0[0], r1[0], r0[1], r1[1]}; OUT = __builtin_bit_cast(bf16x8, w); } while (0)
    ATT_PK4(p0, 0, pa0); ATT_PK4(p0, 8, pa1); ATT_PK4(p1, 0, pa2); ATT_PK4(p1, 8, pa3);
#undef ATT_PK4
    return alpha;
}
#define ATT_TRRD(dst, off) asm volatile("ds_read_b64_tr_b16 %0, %1 offset:%2" : "=&v"(dst) : "v"(vb0), "i"(off) : "memory")
#define ATT_FRAG(l, h) (bf16x8){l[0], l[1], l[2], l[3], h[0], h[1], h[2], h[3]}

namespace mla {
constexpr int KROW = 400, SHM_K = 64 * KROW, SHM_V = 16384, OFF_V = 0, OFF_K = 2 * SHM_V, OFF_WS = OFF_K + 2 * SHM_K, LDS_NEED = OFF_WS + 8 * 256;
template <int VB> __device__ __forceinline__ void pv_tile(f32x16* o, int vb0, bf16x8 pa0, bf16x8 pa1, bf16x8 pa2, bf16x8 pa3) {
#define MLA_PV_D0(d0) do { s16x4 l0, l1, l2, l3, h0, h1, h2, h3; constexpr int b_ = OFF_V + VB * SHM_V + (d0) * 512;     \
        ATT_TRRD(l0, b_); ATT_TRRD(h0, b_ + 2048); ATT_TRRD(l1, b_ + 4096); ATT_TRRD(h1, b_ + 6144); ATT_TRRD(l2, b_ + 8192); ATT_TRRD(h2, b_ + 10240); ATT_TRRD(l3, b_ + 12288); ATT_TRRD(h3, b_ + 14336); \
        asm volatile("s_waitcnt lgkmcnt(0)" ::: "memory"); ATT_SBAR(); \
        o[d0] = __builtin_amdgcn_mfma_f32_32x32x16_bf16(pa0, ATT_FRAG(l0, h0), o[d0], 0, 0, 0); o[d0] = __builtin_amdgcn_mfma_f32_32x32x16_bf16(pa1, ATT_FRAG(l1, h1), o[d0], 0, 0, 0); \
        o[d0] = __builtin_amdgcn_mfma_f32_32x32x16_bf16(pa2, ATT_FRAG(l2, h2), o[d0], 0, 0, 0); o[d0] = __builtin_amdgcn_mfma_f32_32x32x16_bf16(pa3, ATT_FRAG(l3, h3), o[d0], 0, 0, 0); } while (0)
    MLA_PV_D0(0); MLA_PV_D0(1); MLA_PV_D0(2); MLA_PV_D0(3);
#undef MLA_PV_D0
}
template <int KB> __device__ __forceinline__ void qkt(f32x16& p0, f32x16& p1, LAS unsigned char* lds, int r32, int hi, const bf16x8* qr) {
    p0 = f32x16{}; p1 = f32x16{};
    const LAS unsigned char* kb = lds + OFF_K + KB * SHM_K + r32 * KROW + hi * 16;
#pragma unroll
    for (int d0 = 0; d0 < 12; ++d0) { const bf16x8 b0 = *(const LAS bf16x8*)(kb + d0 * 32), b1 = *(const LAS bf16x8*)(kb + d0 * 32 + 32 * KROW);
        p0 = __builtin_amdgcn_mfma_f32_32x32x16_bf16(b0, qr[d0], p0, 0, 0, 0); p1 = __builtin_amdgcn_mfma_f32_32x32x16_bf16(b1, qr[d0], p1, 0, 0, 0); }
}
__device__ __forceinline__ void unit(int b, int h, int qb, unsigned char* ws, LAS unsigned char* lds) {
    int tid_ = threadIdx.x; asm volatile("" : "+v"(tid_));
    const int tid = tid_, wid = __builtin_amdgcn_readfirstlane(tid >> 6), lane = tid & 63, r32 = lane & 31, hi = lane >> 5;
    const size_t rowbase = (size_t)b * SEQ; const int q0 = qb * 256, q0w = q0 + wid * 32;
    const bf16_t* Kh = (const bf16_t*)(ws + WS_K) + rowbase * 1536 + h * 192; const bf16_t* Vh = (const bf16_t*)(ws + WS_V) + rowbase * 1024 + h * 128;
    bf16x8 qr[12];
    { const bf16_t* Qw = (const bf16_t*)(ws + WS_Q) + (rowbase + q0w + r32) * 1536 + h * 192 + hi * 8;
#pragma unroll
      for (int d0 = 0; d0 < 12; ++d0) qr[d0] = *(const bf16x8*)(Qw + d0 * 16); }
    int kgo[3], klo[3];
#pragma unroll
    for (int i = 0; i < 3; ++i) { const int e = tid + 512 * i, row = e / 24, ch = e % 24; kgo[i] = row * 1536 + ch * 8; klo[i] = row * KROW + ch * 16; }
    const int sr = tid >> 4, sc = (tid & 15) * 8, vgo = sr * 1024 + sc, vst0 = v_st<128>(sr, sc), vst1 = v_st<128>(32 + sr, sc);
    const int vb0 = (int)(uintptr_t)(lds + OFF_V) + v_rd_base(lane);
    LAS float* wsf = (LAS float*)(lds + OFF_WS) + wid * 64;
    const int NT = 4 * (qb + 1);
    bf16x8 sk0, sk1, sk2, sv0, sv1;
#define MLA_LOAD(t) do { const bf16_t* kp = Kh + (size_t)(t) * 64 * 1536; const bf16_t* vp = Vh + (size_t)(t) * 64 * 1024; \
        sk0 = *(const bf16x8*)(kp + kgo[0]); sk1 = *(const bf16x8*)(kp + kgo[1]); sk2 = *(const bf16x8*)(kp + kgo[2]); sv0 = *(const bf16x8*)(vp + vgo); sv1 = *(const bf16x8*)(vp + vgo + 32 * 1024); } while (0)
#define MLA_WRITE(B) do { LAS unsigned char* kd = lds + OFF_K + (B) * SHM_K; LAS unsigned char* vd = lds + OFF_V + (B) * SHM_V; \
        *(LAS bf16x8*)(kd + klo[0]) = sk0; *(LAS bf16x8*)(kd + klo[1]) = sk1; *(LAS bf16x8*)(kd + klo[2]) = sk2; *(LAS bf16x8*)(vd + vst0) = sv0; *(LAS bf16x8*)(vd + vst1) = sv1; } while (0)
    float m_reg = -1e30f, l_reg = 0.f; f32x16 o[4] = {};
    MLA_LOAD(0); MLA_WRITE(0); MLA_LOAD(1);
    __syncthreads();
#define MLA_STEP(t, B) do { \
        if ((t) + 1 < NT) { MLA_WRITE((B) ^ 1); } \
        if ((t) + 2 < NT) { MLA_LOAD((t) + 2); } \
        ATT_SBAR(); \
        f32x16 p0, p1; qkt<B>(p0, p1, lds, r32, hi, qr); \
        if (64 * (t) + 63 > q0w) { const int dq = q0w + r32 - 64 * (t) - 4 * hi; const float NEG = -__builtin_inff(); \
            _Pragma("unroll") for (int r = 0; r < 16; ++r) { const int c = (r & 3) + 8 * (r >> 2); if (c > dq) p0[r] = NEG; if (c + 32 > dq) p1[r] = NEG; } } \
        bf16x8 pa0, pa1, pa2, pa3; const float alpha = softmax_tile(p0, p1, m_reg, l_reg, pa0, pa1, pa2, pa3); \
        if (__any(alpha < 1.f)) { if (hi == 0) wsf[r32] = alpha; asm volatile("s_waitcnt lgkmcnt(0)" ::: "memory"); \
            _Pragma("unroll") for (int d_ = 0; d_ < 4; ++d_) _Pragma("unroll") for (int r = 0; r < 16; ++r) o[d_][r] *= wsf[crow(r, hi)]; } \
        ATT_SBAR(); pv_tile<B>(o, vb0, pa0, pa1, pa2, pa3); \
        __syncthreads(); } while (0)
    for (int t = 0; t < NT; t += 2) { MLA_STEP(t, 0); MLA_STEP(t + 1, 1); }
#undef MLA_STEP
#undef MLA_LOAD
#undef MLA_WRITE
    if (hi == 0) wsf[32 + r32] = l_reg; asm volatile("s_waitcnt lgkmcnt(0)" ::: "memory");
    bf16_t* Ow = (bf16_t*)(ws + WS_O) + (rowbase + q0w) * 1024 + h * 128;
#pragma unroll
    for (int r = 0; r < 16; ++r) { const int orow = crow(r, hi); const float rl = __builtin_amdgcn_rcpf(wsf[32 + orow]);
#pragma unroll
        for (int d0 = 0; d0 < 4; ++d0) { const float v = o[d0][r] * rl; const float vn = __shfl_xor(v, 1);
            if ((r32 & 1) == 0) *(unsigned*)(Ow + (size_t)orow * 1024 + d0 * 32 + r32) = cvtpk(v, vn); } }
    __syncthreads();
}
__device__ __forceinline__ void phase(int vcu, unsigned char* ws, LAS unsigned char* lds) {
    const int bh = vcu >> 4, s = vcu & 15;
    if (bh >= BATCH * NHM) return;
    unit(bh >> 3, bh & 7, 31 - s, ws, lds);
    unit(bh >> 3, bh & 7, s, ws, lds);
}
}

namespace swa {
constexpr int KROW = 144, SHM_K = 64 * KROW, SHM_V = 8192, OFF_V = 0, OFF_K = 3 * SHM_V, OFF_WS = OFF_K + 3 * SHM_K, LDS_NEED = OFF_WS + 8 * 256;
template <int T> __device__ __forceinline__ void tile(f32x16* o, float& m_reg, float& l_reg, const bf16x8* qr, LAS unsigned char* lds, LAS float* wsf, int vb0, int r32, int hi, int qpos, int kbase, unsigned weff, float slope2) {
    constexpr int t = T;
    f32x16 p0 = {}, p1 = {};
    { const LAS unsigned char* kb = lds + OFF_K + t * SHM_K + r32 * KROW + hi * 16;
#pragma unroll
      for (int d0 = 0; d0 < 4; ++d0) { const bf16x8 b0 = *(const LAS bf16x8*)(kb + d0 * 32), b1 = *(const LAS bf16x8*)(kb + d0 * 32 + 32 * KROW);
          p0 = __builtin_amdgcn_mfma_f32_32x32x16_bf16(b0, qr[d0], p0, 0, 0, 0); p1 = __builtin_amdgcn_mfma_f32_32x32x16_bf16(b1, qr[d0], p1, 0, 0, 0); } }
    { const int dq = qpos - (kbase + 64 * t) - 4 * hi; const float NEG = -__builtin_inff();
#pragma unroll
      for (int r = 0; r < 16; ++r) { const int c = (r & 3) + 8 * (r >> 2); const int d0_ = dq - c, d1_ = dq - c - 32;
          p0[r] = (unsigned)d0_ < weff ? p0[r] - slope2 * (float)d0_ : NEG; p1[r] = (unsigned)d1_ < weff ? p1[r] - slope2 * (float)d1_ : NEG; } }
    bf16x8 pa0, pa1, pa2, pa3; const float alpha = softmax_tile(p0, p1, m_reg, l_reg, pa0, pa1, pa2, pa3);
    if (__any(alpha < 1.f)) { if (hi == 0) wsf[r32] = alpha; asm volatile("s_waitcnt lgkmcnt(0)" ::: "memory");
#pragma unroll
        for (int d_ = 0; d_ < 2; ++d_)
#pragma unroll
            for (int r = 0; r < 16; ++r) o[d_][r] *= wsf[crow(r, hi)]; }
    ATT_SBAR();
#define SWA_PV_D0(d0) do { s16x4 l0, l1, l2, l3, h0, h1, h2, h3; constexpr int b_ = OFF_V + t * SHM_V + (d0) * 512;     \
    ATT_TRRD(l0, b_); ATT_TRRD(h0, b_ + 1024); ATT_TRRD(l1, b_ + 2048); ATT_TRRD(h1, b_ + 3072); ATT_TRRD(l2, b_ + 4096); ATT_TRRD(h2, b_ + 5120); ATT_TRRD(l3, b_ + 6144); ATT_TRRD(h3, b_ + 7168); \
    asm volatile("s_waitcnt lgkmcnt(0)" ::: "memory"); ATT_SBAR(); \
    o[d0] = __builtin_amdgcn_mfma_f32_32x32x16_bf16(pa0, ATT_FRAG(l0, h0), o[d0], 0, 0, 0); o[d0] = __builtin_amdgcn_mfma_f32_32x32x16_bf16(pa1, ATT_FRAG(l1, h1), o[d0], 0, 0, 0); \
    o[d0] = __builtin_amdgcn_mfma_f32_32x32x16_bf16(pa2, ATT_FRAG(l2, h2), o[d0], 0, 0, 0); o[d0] = __builtin_amdgcn_mfma_f32_32x32x16_bf16(pa3, ATT_FRAG(l3, h3), o[d0], 0, 0, 0); } while (0)
    SWA_PV_D0(0); SWA_PV_D0(1);
#undef SWA_PV_D0
}
__device__ __forceinline__ void unit(int b, int kvh, int qblk, unsigned char* ws, const float* sinks, LAS unsigned char* lds) {
    int tid_ = threadIdx.x; asm volatile("" : "+v"(tid_));
    const int tid = tid_, wid = __builtin_amdgcn_readfirstlane(tid >> 6), lane = tid & 63, r32 = lane & 31, hi = lane >> 5;
    const size_t rowbase = (size_t)b * SEQ; const int q0 = qblk * 64, q0w = q0 + (wid & 1) * 32, hq = kvh * 4 + (wid >> 1), kbase = q0 - 128;
    const bf16_t* Kh = (const bf16_t*)(ws + WS_K1) + rowbase * 256 + kvh * 64; const bf16_t* Vh = (const bf16_t*)(ws + WS_V1) + rowbase * 256 + kvh * 64;
#pragma unroll
    for (int i = 0; i < 3; ++i) { const int e = tid + 512 * i, row = e >> 3, ch = e & 7; int key = kbase + row; key = key < 0 ? 0 : key;
        const bf16x8 kv = *(const bf16x8*)(Kh + (size_t)key * 256 + ch * 8), vv = *(const bf16x8*)(Vh + (size_t)key * 256 + ch * 8);
        *(LAS bf16x8*)(lds + OFF_K + row * KROW + ch * 16) = kv; *(LAS bf16x8*)(lds + OFF_V + (row >> 6) * SHM_V + v_st<64>(row & 63, ch * 8)) = vv; }
    bf16x8 qr[4];
    { const bf16_t* Qw = (const bf16_t*)(ws + WS_Q1) + (rowbase + q0w + r32) * 1024 + hq * 64 + hi * 8;
#pragma unroll
      for (int d0 = 0; d0 < 4; ++d0) qr[d0] = *(const bf16x8*)(Qw + d0 * 16); }
    const int vb0 = (int)(uintptr_t)(lds + OFF_V) + v_rd_base(lane);
    LAS float* wsf = (LAS float*)(lds + OFF_WS) + wid * 64;
    const float slope2 = __builtin_amdgcn_exp2f(-0.5f * (float)(hq + 1)) * LOG2E;
    float m_reg = sinks[hq] * LOG2E, l_reg = 1.f; f32x16 o[2] = {};
    const int qpos = q0w + r32; const unsigned weff = (unsigned)(qpos + 1 < SWIN ? qpos + 1 : SWIN);
    __syncthreads();
    tile<0>(o, m_reg, l_reg, qr, lds, wsf, vb0, r32, hi, qpos, kbase, weff, slope2); tile<1>(o, m_reg, l_reg, qr, lds, wsf, vb0, r32, hi, qpos, kbase, weff, slope2); tile<2>(o, m_reg, l_reg, qr, lds, wsf, vb0, r32, hi, qpos, kbase, weff, slope2);
    if (hi == 0) wsf[32 + r32] = l_reg; asm volatile("s_waitcnt lgkmcnt(0)" ::: "memory");
    bf16_t* Ow = (bf16_t*)(ws + WS_O) + (rowbase + q0w) * 1024 + hq * 64;
#pragma unroll
    for (int r = 0; r < 16; ++r) { const int orow = crow(r, hi); const float rl = __builtin_amdgcn_rcpf(wsf[32 + orow]);
#pragma unroll
        for (int d0 = 0; d0 < 2; ++d0) { const float v = o[d0][r] * rl; const float vn = __shfl_xor(v, 1);
            if ((r32 & 1) == 0) *(unsigned*)(Ow + (size_t)orow * 1024 + d0 * 32 + r32) = cvtpk(v, vn); } }
    __syncthreads();
}
__device__ __forceinline__ void phase(int vcu, int G, unsigned char* ws, const float* sinks, LAS unsigned char* lds) {
    for (int u = vcu; u < BATCH * SHK * (SEQ / 64); u += G) { const int bk = u >> 7; unit(bk >> 2, bk & 3, u & 127, ws, sinks, lds); }
}
}
}
#define FAST_ATTN_MLA() do { unsigned char* ws_ = ld_params(ka).ws; att::mla::phase(F.vcu, ws_, F.lds + RING_OFF); } while (0)
#define FAST_ATTN_SWA() do { const Params p_ = ld_params(ka); att::swa::phase(F.vcu, F.G, p_.ws, p_.swa_sinks, F.lds + RING_OFF); } while (0)
#ifndef REPEAT_PH
#define REPEAT_PH (-1)
#endif
struct Args { Params p; int ph_lo, ph_hi, li, pad; };
typedef const __attribute__((address_space(4))) Args* KArgs;
__device__ __forceinline__ Params ld_params(KArgs ka) { asm volatile("" : "+s"(ka)); Params p;
    const __attribute__((address_space(4))) unsigned long long* s = (const __attribute__((address_space(4))) unsigned long long*)ka; unsigned long long* d = (unsigned long long*)&p;
#pragma unroll
    for (int i = 0; i < (int)(sizeof(Params) / 8); ++i) d[i] = s[i];
    return p; }
__global__ void __launch_bounds__(NWAVES * 64, 2) mega(Args args) {
    extern __shared__ __attribute__((aligned(16))) unsigned char lds[];
    KArgs ka = (KArgs)__builtin_amdgcn_kernarg_segment_ptr();
    Frame F;
    F.lds = (LAS unsigned char*)lds;
    volatile LAS unsigned* MISC = (volatile LAS unsigned*)(F.lds + MISC_OFF);
    F.tid = threadIdx.x; F.lane = F.tid & 63; F.wave = __builtin_amdgcn_readfirstlane(F.tid >> 6);
#define REFRESH_F() do { int t_ = threadIdx.x; asm volatile("" : "+v"(t_)); F.tid = t_; F.lane = t_ & 63; } while (0)
    F.G = gridDim.x; { const int bx = blockIdx.x; F.vcu = (F.G % 8 == 0) ? (bx % 8) * (F.G / 8) + bx / 8 : bx; }
    for (int u = F.tid; u < (LDS_BYTES - LDSCTL_OFF) / 4; u += NWAVES * 64) ((LAS unsigned*)(F.lds + LDSCTL_OFF))[u] = 0u;
    __syncthreads();
    const int lo = args.ph_lo, hi = args.ph_hi;
    XcdBarrier bar = xcd_barrier_post((unsigned*)(ld_params(ka).ws + WS_CTL) + CW_BAR + args.li * XCD_BAR_WORDS, MISC + 8);
#ifndef PHASE_ON
#define PHASE_ON(k) true
#endif
#define IN(k) (PHASE_ON(k) && lo <= (k) && (k) < hi)
#define SEAM(k) do { if (IN(k) && IN((k) + 1)) xcd_barrier(bar); } while (0)
    if (IN(0)) { const Params p = ld_params(ka); REFRESH_F(); p0a(F, p); if (REPEAT_PH == 0) { xcd_barrier(bar); p0a(F, p); } SEAM(0); }
    if (IN(1)) { const Params p = ld_params(ka); REFRESH_F(); p0b(F, p); if (REPEAT_PH == 1) { xcd_barrier(bar); p0b(F, p); } SEAM(1); }
    if (IN(2)) { unsigned char* ws = ld_params(ka).ws; pg8::Gemm g{(const bf16_t*)(ws + WS_XN), (const bf16_t*)(ws + WS_WD), 1024, ND, 1024}; pg8::StaticOrder S; S.init(M, ND, F.G, (int)blockIdx.x);
        pg8::gemm_phase<pg8::EpiDown, false>(F.lds + RING_OFF, g, S, pg8::EpiDown{ws}); SEAM(2); }
    if (IN(3)) {
        { unsigned char* ws = ld_params(ka).ws; pg8::Gemm g{(const bf16_t*)(ws + WS_RAW), (const bf16_t*)(ws + WS_WUQ), ND, 1536, QL}; pg8::StaticOrder S; S.init(M, 1536, F.G, (int)blockIdx.x);
          pg8::gemm_phase<pg8::EpiQ, true>(F.lds + RING_OFF, g, S, pg8::EpiQ{ws}); }
        { unsigned char* ws = ld_params(ka).ws; pg8::Gemm g{(const bf16_t*)(ws + WS_RAW) + 384, (const bf16_t*)(ws + WS_WUKV), ND, 2048, KVL}; pg8::StaticOrder S; S.init(M, 2048, F.G, (int)(F.G - 1 - blockIdx.x));
          pg8::gemm_phase<pg8::EpiKV, true>(F.lds + RING_OFF, g, S, pg8::EpiKV{ws}); }
        SEAM(3); }
    if (IN(4)) { FAST_ATTN_MLA(); if (REPEAT_PH == 4) { xcd_barrier(bar); FAST_ATTN_MLA(); } SEAM(4); }
#pragma unroll 1
    for (int l = 0; l < 2; ++l) {
        const int pb = l == 0 ? 5 : 10;
        if (IN(pb)) { const Params p = ld_params(ka); unsigned char* ws = p.ws;
            pg8::Gemm g{(const bf16_t*)(ws + WS_O), (const bf16_t*)(ws + (l == 0 ? WS_WO0 : WS_WO1)), 1024, 1024, 1024}; pg8::StaticOrder S; S.init(M, 1024, F.G, (int)blockIdx.x);
            pg8::EpiRes E{l == 0 ? p.x : p.out, p.out, modp(p, l, 0, 2), l == 0 ? nullptr : p.swa_b_o, p.g_mlp + l * 1024, modp(p, l, 0, 4), ws};
            pg8::gemm_phase<pg8::EpiRes, false>(F.lds + RING_OFF, g, S, E); SEAM(pb); }
        if (IN(pb + 1)) { unsigned char* ws = ld_params(ka).ws;
            pg8::Gemm g{(const bf16_t*)(ws + WS_XN), (const bf16_t*)(ws + (l == 0 ? WS_W10 : WS_W11)), 1024, FF, 1024}; pg8::StaticOrder S; S.init(M, FF, F.G, (int)blockIdx.x);
            pg8::EpiUp E{(const float*)(ws + WS_BIASU) + l * 2 * FF, ws};
            pg8::gemm_phase<pg8::EpiUp, true>(F.lds + RING_OFF, g, S, E); if (REPEAT_PH == 6 && l == 0) { xcd_barrier(bar); pg8::gemm_phase<pg8::EpiUp, true>(F.lds + RING_OFF, g, S, E); } SEAM(pb + 1); }
        if (IN(pb + 2)) { const Params p = ld_params(ka); unsigned char* ws = p.ws;
            pg8::Gemm g{(const bf16_t*)(ws + WS_H), (const bf16_t*)(ws + (l == 0 ? WS_W20 : WS_W21)), FF, 1024, FF}; pg8::StaticOrder S; S.init(M, 1024, F.G, (int)blockIdx.x);
            pg8::EpiRes E{p.out, p.out, modp(p, l, 0, 5), nullptr, l == 0 ? p.g_mix + 1024 : nullptr, l == 0 ? modp(p, 1, 0, 1) : nullptr, ws};
            pg8::gemm_phase<pg8::EpiRes, false>(F.lds + RING_OFF, g, S, E); SEAM(pb + 2); }
        if (l == 0) {
            if (IN(8)) { unsigned char* ws = ld_params(ka).ws; pg8::Gemm g{(const bf16_t*)(ws + WS_XN), (const bf16_t*)(ws + WS_WQKV), 1024, 1536, 1024}; pg8::StaticOrder S; S.init(M, 1536, F.G, (int)blockIdx.x);
                pg8::gemm_phase<pg8::EpiQKV1, true>(F.lds + RING_OFF, g, S, pg8::EpiQKV1{ws}); SEAM(8); }
            if (IN(9)) { FAST_ATTN_SWA(); if (REPEAT_PH == 9) { xcd_barrier(bar); FAST_ATTN_SWA(); } SEAM(9); }
        }
    }
    if (IN(13)) { const Params p = ld_params(ka); REFRESH_F(); p_final(F, p); }
#undef IN
#undef SEAM
}

static Params make_params(void* const* d_in, void* d_out, void* d_ws) {
    Params p{};
    p.x = (const float*)d_in[0]; p.c = (const float*)d_in[1]; p.pos = (const int*)d_in[2];
    p.w_ada = (const float*)d_in[3]; p.b_ada = (const float*)d_in[4]; p.g_mix = (const float*)d_in[5]; p.g_mlp = (const float*)d_in[6];
    p.w_dq = (const float*)d_in[7]; p.g_q = (const float*)d_in[8]; p.w_uq = (const float*)d_in[9]; p.w_dkv = (const float*)d_in[10];
    p.g_kv = (const float*)d_in[11]; p.w_ukv = (const float*)d_in[12]; p.mla_w_o = (const float*)d_in[13];
    p.swa_w_qkv = (const float*)d_in[14]; p.swa_b_qkv = (const float*)d_in[15]; p.swa_sinks = (const float*)d_in[16];
    p.swa_w_o = (const float*)d_in[17]; p.swa_b_o = (const float*)d_in[18]; p.w_ff1 = (const float*)d_in[19]; p.w_ff2 = (const float*)d_in[20];
    p.g_final = (const float*)d_in[21];
    p.out = (float*)d_out; p.ws = (unsigned char*)d_ws;
    return p;
}
#ifndef NO_NAIVE
template <class E> static void ngemm(hipStream_t st, const Params& p, size_t a_off, int lda, int wid, E e) {
    nv::gemm<E><<<dim3(w_N(wid) / 64, M / 64), 256, 0, st>>>((const bf16_t*)(p.ws + a_off), (const bf16_t*)(p.ws + w_off(wid)), lda, w_N(wid), w_K(wid), 0, e);
}
static void naive_phase(int ph, const Params& p, hipStream_t stream) {
    switch (ph) {
    case 0: for (int id = 0; id < 10; ++id) nv::wconv<<<(unsigned)(((size_t)w_N(id) * w_K(id) + 255) / 256), 256, 0, stream>>>(p, id, 0);
            nv::mod<<<96, 256, 0, stream>>>(p); nv::rope<<<M * 32 / 256, 256, 0, stream>>>(p); break;
    case 1: nv::bias<<<82, 256, 0, stream>>>(p); nv::prep0<<<M / 4, 256, 0, stream>>>(p); break;
    case 2: ngemm(stream, p, WS_XN, 1024, 0, nv::E1{p}); nv::ssq1<<<M / 4, 256, 0, stream>>>(p); break;
    case 3: ngemm(stream, p, WS_RAW, ND, 1, nv::E2q{p}); ngemm(stream, p, WS_RAW + 384 * 2, ND, 2, nv::E2kv{p}); break;
    case 4: nv::attn<false><<<BATCH * NHM * SEQ / 4, 256, 0, stream>>>(p); break;
    case 5: ngemm(stream, p, WS_O, 1024, 3, nv::E4{p, 0, 0}); nv::ssqx<<<M / 4, 256, 0, stream>>>(p); break;
    case 6: ngemm(stream, p, WS_XN, 1024, 4, nv::E5{p, 0, 0}); break;
    case 7: ngemm(stream, p, WS_H, FF, 5, nv::E6{p, 0, 0}); nv::ssqx<<<M / 4, 256, 0, stream>>>(p); break;
    case 8: ngemm(stream, p, WS_XN, 1024, 6, nv::E7{p}); break;
    case 9: nv::attn<true><<<BATCH * SHQ * SEQ / 4, 256, 0, stream>>>(p); break;
    case 10: ngemm(stream, p, WS_O, 1024, 7, nv::E4{p, 1, 0}); nv::ssqx<<<M / 4, 256, 0, stream>>>(p); break;
    case 11: ngemm(stream, p, WS_XN, 1024, 8, nv::E5{p, 1, 0}); break;
    case 12: ngemm(stream, p, WS_H, FF, 9, nv::E6{p, 1, 0}); nv::ssqx<<<M / 4, 256, 0, stream>>>(p); break;
    default: nv::final_norm<<<M / 4, 256, 0, stream>>>(p); break;
    }
}
#endif
extern "C" void kernel_launch(void* const* d_in, const int* in_sizes, int n_in, void* d_out, int out_size, void* d_ws, size_t ws_size, hipStream_t stream) {
    static int grid = 0;
    if (grid == 0) {
        if (n_in != 22 || in_sizes[0] != M * DM || out_size != M * DM || ws_size < WS_END) {
            fprintf(stderr, "kernel_launch: unexpected shapes (n_in %d, in0 %d, out %d, ws %zu)\n", n_in, n_in > 0 ? in_sizes[0] : -1, out_size, ws_size); grid = -1; return; }
        int dev = 0, cus = 0, per_cu = 0;
        if (hipGetDevice(&dev) != hipSuccess || hipDeviceGetAttribute(&cus, hipDeviceAttributeMultiprocessorCount, dev) != hipSuccess) { grid = -1; return; }
        if (hipFuncSetAttribute((const void*)mega, hipFuncAttributeMaxDynamicSharedMemorySize, LDS_BYTES) != hipSuccess) { fprintf(stderr, "kernel_launch: hipFuncSetAttribute failed\n"); grid = -1; return; }
        if (hipOccupancyMaxActiveBlocksPerMultiprocessor(&per_cu, (const void*)mega, NWAVES * 64, LDS_BYTES) != hipSuccess || per_cu < 1)
            fprintf(stderr, "kernel_launch: note: occupancy query reports %d workgroups per CU\n", per_cu);
        (void)hipGetLastError();
        grid = cus;
    }
    if (grid < 0) return;
    const Params p = make_params(d_in, d_out, d_ws);
    (void)hipMemsetAsync((char*)d_ws + WS_CTL, 0, CTL_ZERO_BYTES, stream);
    static const bool FAST[N_PHASES] = FAST_PHASES;
    int li = 0, i = 0;
    while (i < N_PHASES) {
        if (FAST[i]) { int j = i; while (j < N_PHASES && FAST[j]) ++j;
            Args a{}; a.p = p; a.ph_lo = i; a.ph_hi = j; a.li = li++;
            hipLaunchKernelGGL(mega, dim3(grid), dim3(NWAVES * 64), LDS_BYTES, stream, a);
            i = j; }
        else {
#ifndef NO_NAIVE
            naive_phase(i, p, stream);
#endif
            ++i; }
    }
}
```
